# Optimizing an MI355X kernel written in HIP

```python
import math
import jax, jax.numpy as jnp
from jax import lax
import numpy as np

D_MODEL = 2048
BATCH = 4
SEQ = 4096
DEPTH = 4

N_EVEN = (DEPTH + 1) // 2
N_ODD = DEPTH // 2

CONV_CH = D_MODEL // 2
CONV_WIDTH = 31
SGU_CH = D_MODEL // 2
SGU_GROUPS = 8
SGU_GROUP_DIM = SGU_CH // SGU_GROUPS
CHUNK = 128
IN_AB = 2 * CONV_CH + 2 * SGU_CH
C_HEADS = 8
C_HEAD_DIM = 128
QK_W = C_HEADS * 2 * C_HEAD_DIM
V_W = C_HEADS * 2 * C_HEAD_DIM
Q_BLOCK = 128
NUM_BUCKETS = 32
MAX_DISTANCE = 128
D_FF = ((8 * D_MODEL // 3 + 255) // 256) * 256
EPS = 1e-6

kernel_name = "hybrid_conv_sgu_diffattn_encoder"


def rms_norm(x, g):
    xf = x.astype(jnp.float32)
    y = xf * lax.rsqrt(jnp.mean(xf * xf, axis=-1, keepdims=True) + EPS)
    return (y * g.astype(jnp.float32)).astype(x.dtype)


def layer_norm(x, g, b):
    xf = x.astype(jnp.float32)
    mu = jnp.mean(xf, axis=-1, keepdims=True)
    xc = xf - mu
    y = xc * lax.rsqrt(jnp.mean(xc * xc, axis=-1, keepdims=True) + EPS)
    return (y * g.astype(jnp.float32) + b.astype(jnp.float32)).astype(x.dtype)


def t5_bucket(rel):
    nb = NUM_BUCKETS // 2
    max_exact = nb // 2
    ret = jnp.where(rel > 0, nb, 0)
    n = jnp.abs(rel)
    nf = jnp.maximum(n, 1).astype(jnp.float32)
    large = max_exact + (jnp.log(nf / max_exact) / math.log(MAX_DISTANCE / max_exact)
                         * (nb - max_exact)).astype(jnp.int32)
    large = jnp.minimum(large, nb - 1)
    return ret + jnp.where(n < max_exact, n, large)


def conv_sgu_mixer(h, w_in, dw_k, cg, cb, sg, sb, w_sp, b_sp, w_out):
    B_, S_, _ = h.shape
    z = h @ w_in
    a_lin, a_gate, u, v = jnp.split(z, [CONV_CH, 2 * CONV_CH, 2 * CONV_CH + SGU_CH], axis=-1)
    a = a_lin * jax.nn.sigmoid(a_gate)
    pad = CONV_WIDTH // 2
    a = lax.conv_general_dilated(a, dw_k[:, None, :].astype(a.dtype), window_strides=(1,),
                                 padding=[(pad, pad)], dimension_numbers=('NWC', 'WIO', 'NWC'),
                                 feature_group_count=CONV_CH)
    a = jax.nn.silu(layer_norm(a, cg, cb))
    zu = jax.nn.gelu(u, approximate=False)
    zv = layer_norm(jax.nn.gelu(v, approximate=False), sg, sb)
    n_chunks = S_ // CHUNK
    zv = zv.reshape(B_, n_chunks, CHUNK, SGU_GROUPS, SGU_GROUP_DIM)
    s = jnp.einsum('gpq,bnqgc->bnpgc', w_sp, zv) + b_sp.T[:, :, None]
    bo = zu * s.reshape(B_, S_, SGU_CH)
    return jnp.concatenate([a, bo], axis=-1) @ w_out


def diff_attention(h, w_qkv, lam_qk, subln_g, w_out, rel_bias, lambda_init):
    B_, S_, _ = h.shape
    qkv = h @ w_qkv
    q, k, v = jnp.split(qkv, [QK_W, 2 * QK_W], axis=-1)
    q = q.reshape(B_, S_, C_HEADS, 2, C_HEAD_DIM) * (C_HEAD_DIM ** -0.5)
    k = k.reshape(B_, S_, C_HEADS, 2, C_HEAD_DIM)
    v = v.reshape(B_, S_, C_HEADS, 2 * C_HEAD_DIM)
    lf = lam_qk.astype(jnp.float32)
    lam = jnp.exp(jnp.sum(lf[0] * lf[1])) - jnp.exp(jnp.sum(lf[2] * lf[3])) + lambda_init
    nblk = S_ // Q_BLOCK
    qb = q.reshape(B_, nblk, Q_BLOCK, C_HEADS, 2, C_HEAD_DIM).transpose(1, 0, 2, 3, 4, 5)
    k_pos = jnp.arange(S_, dtype=jnp.int32)

    def block(args):
        q_blk, i = args
        q_pos = i * Q_BLOCK + jnp.arange(Q_BLOCK, dtype=jnp.int32)
        bucket = t5_bucket(k_pos[None, :] - q_pos[:, None])
        bias = jnp.take(rel_bias, bucket, axis=0).transpose(2, 0, 1)
        logits = (jnp.einsum('bqhcd,bkhcd->bhcqk', q_blk, k).astype(jnp.float32)
                  + bias[None, :, None].astype(jnp.float32))
        p = jax.nn.softmax(logits, axis=-1)
        attn = (p[:, :, 0] - lam * p[:, :, 1]).astype(v.dtype)
        return jnp.einsum('bhqk,bkhe->bqhe', attn, v)

    o = lax.map(block, (qb, jnp.arange(nblk, dtype=jnp.int32)))
    o = o.transpose(1, 0, 2, 3, 4).reshape(B_, S_, C_HEADS, 2 * C_HEAD_DIM)
    o = rms_norm(o, subln_g) * (1.0 - lambda_init)
    return o.reshape(B_, S_, V_W) @ w_out


def swiglu(h, wg, wu, wd):
    return (jax.nn.silu(h @ wg) * (h @ wu)) @ wd


def setup_inputs(seed: int = 0) -> dict:
    key = jax.random.key(seed)
    ks = jax.random.split(key, 20)
    f32 = jnp.float32
    nrm = lambda k, shape, fan: jax.random.normal(k, shape, f32) * (fan ** -0.5)
    return {
        "x": jax.random.normal(ks[0], (BATCH, SEQ, D_MODEL), f32),
        "norm_g": 1.0 + 0.05 * jax.random.normal(ks[1], (DEPTH, 4, D_MODEL), f32),
        "w_in_ab": nrm(ks[2], (N_EVEN, D_MODEL, IN_AB), D_MODEL),
        "dw_kernel": nrm(ks[3], (N_EVEN, CONV_WIDTH, CONV_CH), CONV_WIDTH),
        "conv_ln_g": 1.0 + 0.05 * jax.random.normal(ks[4], (N_EVEN, CONV_CH), f32),
        "conv_ln_b": 0.02 * jax.random.normal(ks[5], (N_EVEN, CONV_CH), f32),
        "sgu_ln_g": 1.0 + 0.05 * jax.random.normal(ks[6], (N_EVEN, SGU_CH), f32),
        "sgu_ln_b": 0.02 * jax.random.normal(ks[7], (N_EVEN, SGU_CH), f32),
        "w_spatial": nrm(ks[8], (N_EVEN, SGU_GROUPS, CHUNK, CHUNK), CHUNK),
        "b_spatial": 1.0 + 0.05 * jax.random.normal(ks[9], (N_EVEN, SGU_GROUPS, CHUNK), f32),
        "w_out_ab": nrm(ks[10], (N_EVEN, CONV_CH + SGU_CH, D_MODEL), CONV_CH + SGU_CH),
        "w_qkv_c": nrm(ks[11], (N_ODD, D_MODEL, 2 * QK_W + V_W), D_MODEL),
        "lambda_qk": 0.1 * jax.random.normal(ks[12], (N_ODD, 4, C_HEAD_DIM), f32),
        "subln_g": 1.0 + 0.05 * jax.random.normal(ks[13], (N_ODD, 2 * C_HEAD_DIM), f32),
        "w_out_c": nrm(ks[14], (N_ODD, V_W, D_MODEL), V_W),
        "rel_bias": 0.5 * jax.random.normal(ks[15], (NUM_BUCKETS, C_HEADS), f32),
        "w_gate": nrm(ks[16], (DEPTH, D_MODEL, D_FF), D_MODEL),
        "w_up": nrm(ks[17], (DEPTH, D_MODEL, D_FF), D_MODEL),
        "w_down": nrm(ks[18], (DEPTH, D_FF, D_MODEL), D_FF),
    }


def reference(x, norm_g, w_in_ab, dw_kernel, conv_ln_g, conv_ln_b, sgu_ln_g, sgu_ln_b,
              w_spatial, b_spatial, w_out_ab, w_qkv_c, lambda_qk, subln_g, w_out_c,
              rel_bias, w_gate, w_up, w_down):
    for l in range(DEPTH):
        h = rms_norm(x, norm_g[l, 0])
        if l % 2 == 0:
            e = l // 2
            m = conv_sgu_mixer(h, w_in_ab[e], dw_kernel[e], conv_ln_g[e], conv_ln_b[e],
                               sgu_ln_g[e], sgu_ln_b[e], w_spatial[e], b_spatial[e], w_out_ab[e])
        else:
            o = l // 2
            lambda_init = 0.8 - 0.6 * math.exp(-0.3 * l)
            m = diff_attention(h, w_qkv_c[o], lambda_qk[o], subln_g[o], w_out_c[o],
                               rel_bias, lambda_init)
        x = x + rms_norm(m, norm_g[l, 1])
        h = rms_norm(x, norm_g[l, 2])
        x = x + rms_norm(swiglu(h, w_gate[l], w_up[l], w_down[l]), norm_g[l, 3])
    return x
```

```cpp
#include <hip/hip_runtime.h>
#include <hip/hip_cooperative_groups.h>
#include <cstdio>
#include <cstdint>
namespace cg = cooperative_groups;

#ifndef N_LAUNCH_MODE
#define N_LAUNCH_MODE 0
#endif

#ifndef DUP_MASK
#define DUP_MASK 0
#endif
#define LAS __attribute__((address_space(3)))
typedef unsigned short bf16_t;
typedef short bf16x8 __attribute__((ext_vector_type(8)));
typedef short s16x4 __attribute__((ext_vector_type(4)));
typedef float f32x2 __attribute__((ext_vector_type(2)));
typedef float f32x4 __attribute__((ext_vector_type(4)));
typedef float f32x16 __attribute__((ext_vector_type(16)));
typedef unsigned u32x2 __attribute__((ext_vector_type(2)));
typedef unsigned u32x4 __attribute__((ext_vector_type(4)));

constexpr int M_TOK = 16384, DM = 2048, SEQ = 4096, NBATCH = 4, DFF = 5632, DEPTH = 4;
constexpr int CONV_CH = 1024, CONV_W = 31, SGU_CH = 1024;
constexpr int IN_AB = 4096, QKV_N = 6144;
constexpr float EPS = 1e-6f;
constexpr float LOG2E = 1.4426950408889634f;

constexpr size_t SZ_WIN = (size_t)IN_AB * DM * 2, SZ_WOAB = (size_t)DM * DM * 2, SZ_WQKV = (size_t)QKV_N * DM * 2, SZ_WOC = (size_t)DM * DM * 2;
constexpr size_t SZ_WGU = (size_t)2 * DFF * DM * 2, SZ_WDN = (size_t)DM * DFF * 2;
constexpr size_t WS_WIN = 0, WS_WOAB = WS_WIN + 2 * SZ_WIN, WS_WQKV = WS_WOAB + 2 * SZ_WOAB, WS_WOC = WS_WQKV + 2 * SZ_WQKV;
constexpr size_t WS_WGU = WS_WOC + 2 * SZ_WOC, WS_WDN = WS_WGU + 4 * SZ_WGU, WS_H = WS_WDN + 4 * SZ_WDN;
constexpr size_t WS_BIG = WS_H + (size_t)M_TOK * DM * 2;
constexpr size_t SZ_BIG = (size_t)M_TOK * (QKV_N + DM) * 2;
constexpr size_t WS_MBUF = WS_BIG + SZ_BIG;
constexpr size_t WS_END = WS_MBUF + (size_t)M_TOK * DM * 4;
constexpr size_t BIG_AG = 0, BIG_ZU = (size_t)M_TOK * 1024 * 2, BIG_GV = 2 * BIG_ZU, BIG_CAT = 3 * BIG_ZU;
constexpr size_t BIG_QKV = 0, BIG_OB = (size_t)M_TOK * QKV_N * 2;
constexpr size_t BIG_ACT = 0;

constexpr int LDS_BYTES = 151552;

__device__ __forceinline__ unsigned cvt_pk_bf16(float lo, float hi) { unsigned r; asm volatile("v_cvt_pk_bf16_f32 %0, %1, %2" : "=v"(r) : "v"(lo), "v"(hi)); return r; }
__device__ __forceinline__ float bf_lo(unsigned v) { return __uint_as_float(v << 16); }
__device__ __forceinline__ float bf_hi(unsigned v) { return __uint_as_float(v & 0xffff0000u); }
__device__ __forceinline__ int otid(int wv) { int l; asm volatile("v_mbcnt_lo_u32_b32 %0, -1, 0\n\tv_mbcnt_hi_u32_b32 %0, -1, %0" : "=v"(l)); return wv * 64 + l; }
#define SWZ_XOR(v, k) __int_as_float(__builtin_amdgcn_ds_swizzle(__float_as_int(v), ((k) << 10) | 0x1f))
#define DPP_F(v, ctrl) __int_as_float(__builtin_amdgcn_update_dpp(0, __float_as_int(v), (ctrl), 0xf, 0xf, false))
__device__ __forceinline__ float wave_sum(float v) {
    v += DPP_F(v, 0xB1); v += DPP_F(v, 0x4E); v += DPP_F(v, 0x141); v += DPP_F(v, 0x140); v += SWZ_XOR(v, 16);
    auto rr = __builtin_amdgcn_permlane32_swap(__float_as_uint(v), __float_as_uint(v), false, false);
    return __uint_as_float(rr[0]) + __uint_as_float(rr[1]);
}
__device__ __forceinline__ float sigmoid_f(float x) { return __builtin_amdgcn_rcpf(1.0f + __builtin_amdgcn_exp2f(-x * LOG2E)); }
__device__ __forceinline__ f32x2 gelu_pk(f32x2 v) {
    const f32x2 av = __builtin_elementwise_abs(v), d = av * 0.2316418882f + 1.0f;
    f32x2 t; t.x = __builtin_amdgcn_rcpf(d.x); t.y = __builtin_amdgcn_rcpf(d.y);
    f32x2 q = t * 0.5307027145f + (-0.7265760135f); q = q * t + 0.7107068705f; q = q * t + (-0.142248368f); q = q * t + 0.127414796f; q = q * t;
    const f32x2 s = (v * v) * (-0.72134752044f);
    f32x2 e; e.x = __builtin_amdgcn_exp2f(s.x); e.y = __builtin_amdgcn_exp2f(s.y);
    const f32x2 m = v * (q * e), r = v - m;
    f32x2 o; o.x = v.x < 0.f ? m.x : r.x; o.y = v.y < 0.f ? m.y : r.y; return o;
}

namespace pg8 {
constexpr int BM = 256, BK = 64, HALF = 128, HTB = HALF * BK * 2, STAGE_BYTES = 8 * HTB, NXCD = 8, WGM = 4;
__host__ __device__ __forceinline__ int lds_byte(int r, int c) { const int st = (r >> 4) * 2 + (c >> 5), rr = r & 15, cc = c & 31, ob = rr * 64 + cc * 2; return st * 1024 + (ob ^ (((ob >> 9) & 1) << 5)); }
__host__ __device__ __forceinline__ void stage_rc(int b, int& R, int& C) { const int st = b / 1024, sb = b % 1024, swz = sb ^ (((sb >> 9) & 1) << 5); R = (st >> 1) * 16 + swz / 64; C = (st & 1) * 32 + (swz % 64) / 2; }
__host__ __device__ __forceinline__ int perm32(int rho) { const int n = rho >> 4, i = rho & 15; return 8 * (i >> 2) + 4 * n + (i & 3); }

struct Unit { int pm, pn; };
struct Gemm { const bf16_t* A; const bf16_t* Bt; int M, N, K; };
struct StaticOrder {
    int nM, nN, nwg, G, c;
    __device__ void init(int M, int N, int G_, int c_) { nM = M / BM; nN = N / BM; nwg = nM * nN; G = G_; c = c_; }
    __device__ bool next(int i, Unit& u) const {
        const long L = (long)i * G + c; if (L >= nwg) return false;
        int wgid = (int)L; { const int q = nwg / NXCD, r = nwg % NXCD, xcd = wgid % NXCD, off = wgid / NXCD; wgid = (xcd < r ? xcd * (q + 1) : r * (q + 1) + (xcd - r) * q) + off; }
        const int nig = WGM * nN, gid = wgid / nig, fm = gid * WGM, gsz = (nM - fm) < WGM ? (nM - fm) : WGM;
        u.pm = fm + ((wgid % nig) % gsz); u.pn = (wgid % nig) / gsz; return true;
    }
    __device__ __forceinline__ void a_ready(const Unit&) const {}
    __device__ __forceinline__ void done(const Unit&) const {}
};

struct EpiF32 {
    static constexpr bool PERM = false, AFTER_DRAIN = false;
    float* C; int ldc;
    __device__ __forceinline__ void operator()(const f32x4 (&acc)[2][2][4][2], const Unit& u, int wr, int wc, int fr, int fq) const {
        const int row0 = u.pm * BM + wr * 64 + fr, col0 = u.pn * BM + wc * 32 + 4 * fq;
#pragma unroll
        for (int ai = 0; ai < 2; ++ai)
#pragma unroll
            for (int m = 0; m < 4; ++m) { float* rowp = C + (size_t)(row0 + ai * HALF + m * 16) * ldc + col0;
#pragma unroll
                for (int bj = 0; bj < 2; ++bj)
#pragma unroll
                    for (int n = 0; n < 2; ++n) *(f32x4*)(rowp + bj * HALF + n * 16) = acc[ai][bj][m][n]; }
    }
};
struct EpiQKV {
    static constexpr bool PERM = true, AFTER_DRAIN = false;
    bf16_t* O; int ldc; int qtiles;
    __device__ __forceinline__ void operator()(const f32x4 (&acc)[2][2][4][2], const Unit& u, int wr, int wc, int fr, int fq) const {
        const int row0 = u.pm * BM + wr * 64 + fr, col0 = u.pn * BM + wc * 32 + 8 * fq;
        const float sc = (u.pn < qtiles) ? 0.08838834764831845f : 1.0f;
#pragma unroll
        for (int ai = 0; ai < 2; ++ai)
#pragma unroll
            for (int m = 0; m < 4; ++m) { bf16_t* rowp = O + (size_t)(row0 + ai * HALF + m * 16) * ldc + col0;
#pragma unroll
                for (int bj = 0; bj < 2; ++bj) { const f32x4 v0 = acc[ai][bj][m][0] * sc, v1 = acc[ai][bj][m][1] * sc;
                    u32x4 w; w.x = cvt_pk_bf16(v0[0], v0[1]); w.y = cvt_pk_bf16(v0[2], v0[3]); w.z = cvt_pk_bf16(v1[0], v1[1]); w.w = cvt_pk_bf16(v1[2], v1[3]);
                    *(u32x4*)(rowp + bj * HALF) = w; } }
    }
};
struct EpiSwiGLU {
    static constexpr bool PERM = true, AFTER_DRAIN = false;
    bf16_t* O; int ldc;
    __device__ __forceinline__ void operator()(const f32x4 (&acc)[2][2][4][2], const Unit& u, int wr, int wc, int fr, int fq) const {
        const int row0 = u.pm * BM + wr * 64 + fr, col0 = u.pn * HALF + wc * 32 + 8 * fq;
#pragma unroll
        for (int ai = 0; ai < 2; ++ai)
#pragma unroll
            for (int m = 0; m < 4; ++m) { bf16_t* rowp = O + (size_t)(row0 + ai * HALF + m * 16) * ldc + col0;
                float v[8];
#pragma unroll
                for (int n = 0; n < 2; ++n)
#pragma unroll
                    for (int j = 0; j < 4; ++j) { const float g = acc[ai][0][m][n][j], up = acc[ai][1][m][n][j]; v[n * 4 + j] = g * sigmoid_f(g) * up; }
                u32x4 w; w.x = cvt_pk_bf16(v[0], v[1]); w.y = cvt_pk_bf16(v[2], v[3]); w.z = cvt_pk_bf16(v[4], v[5]); w.w = cvt_pk_bf16(v[6], v[7]);
                *(u32x4*)rowp = w; }
    }
};
struct EpiGemm1 {
    static constexpr bool PERM = true, AFTER_DRAIN = false;
    bf16_t* AG; bf16_t* ZU; bf16_t* GV;
    __device__ __forceinline__ void operator()(const f32x4 (&acc)[2][2][4][2], const Unit& u, int wr, int wc, int fr, int fq) const {
        const int row0 = u.pm * BM + wr * 64 + fr;
        if (u.pn < 8) {
            const int col0 = u.pn * HALF + wc * 32 + 8 * fq;
#pragma unroll
            for (int ai = 0; ai < 2; ++ai)
#pragma unroll
                for (int m = 0; m < 4; ++m) { bf16_t* rowp = AG + (size_t)(row0 + ai * HALF + m * 16) * 1024 + col0;
                    float v[8];
#pragma unroll
                    for (int n = 0; n < 2; ++n)
#pragma unroll
                        for (int j = 0; j < 4; ++j) v[n * 4 + j] = acc[ai][0][m][n][j] * sigmoid_f(acc[ai][1][m][n][j]);
                    u32x4 w; w.x = cvt_pk_bf16(v[0], v[1]); w.y = cvt_pk_bf16(v[2], v[3]); w.z = cvt_pk_bf16(v[4], v[5]); w.w = cvt_pk_bf16(v[6], v[7]);
                    *(u32x4*)rowp = w; }
        } else {
            bf16_t* O = (u.pn < 12) ? ZU : GV; const int col0 = ((u.pn - 8) & 3) * BM + wc * 32 + 8 * fq;
#pragma unroll
            for (int ai = 0; ai < 2; ++ai)
#pragma unroll
                for (int m = 0; m < 4; ++m) { bf16_t* rowp = O + (size_t)(row0 + ai * HALF + m * 16) * 1024 + col0;
#pragma unroll
                    for (int bj = 0; bj < 2; ++bj) { const f32x4 v0 = acc[ai][bj][m][0], v1 = acc[ai][bj][m][1];
                        const f32x2 a = gelu_pk((f32x2){v0[0], v0[1]}), b = gelu_pk((f32x2){v0[2], v0[3]}), c = gelu_pk((f32x2){v1[0], v1[1]}), d = gelu_pk((f32x2){v1[2], v1[3]});
                        u32x4 w; w.x = cvt_pk_bf16(a.x, a.y); w.y = cvt_pk_bf16(b.x, b.y); w.z = cvt_pk_bf16(c.x, c.y); w.w = cvt_pk_bf16(d.x, d.y);
                        *(u32x4*)(rowp + bj * HALF) = w; } }
        }
    }
};

template <class Epi, class Sched>
__device__ __forceinline__ void gemm_phase(LAS unsigned char* lds, const Gemm g, const Sched& S, const Epi& E, const int wv) {
    const int tid = otid(wv), wid = __builtin_amdgcn_readfirstlane(tid >> 6), lane = tid & 63, wr = wid >> 2, wc = wid & 3, fr = lane & 15, fq = lane >> 4;
    const int K = g.K, nt = K / BK;
    unsigned voffA[2], voffB[2];
#pragma unroll
    for (int i = 0; i < 2; ++i) { int R, C; stage_rc(tid * 16 + i * 8192, R, C); const int Rb = Epi::PERM ? ((R & ~31) + perm32(R & 31)) : R;
        voffA[i] = (unsigned)(R * K + C) * 2u; voffB[i] = (unsigned)(Rb * K + C) * 2u; }
    const size_t kstep = (size_t)(BK * 2);
    const size_t hstep = (size_t)HALF * K * 2;
    const size_t tstep = 2 * hstep;
    const unsigned ldsw = (unsigned)wid * 1024u;
    const int aoff = lds_byte(wr * 64 + fr, fq * 8), boff = lds_byte(wc * 32 + fr, fq * 8);
#define PG8_SA(b, h) (((b) * 2 + (h)) * HTB)
#define PG8_SB(b, h) ((4 + (b) * 2 + (h)) * HTB)
#define PG8_STAGE(bufoff, gbase, voff) do { _Pragma("unroll") for (int _i = 0; _i < 2; ++_i) \
        __builtin_amdgcn_global_load_lds((const unsigned*)((const char*)(gbase) + (voff)[_i]), (LAS unsigned*)(lds + (bufoff) + ldsw + _i * 8192), 16, 0, 0); } while (0)
#define PG8_LDA(dst, b, h) do { _Pragma("unroll") for (int m = 0; m < 4; ++m) _Pragma("unroll") for (int k = 0; k < 2; ++k) dst[m][k] = *(const LAS bf16x8*)(lds + PG8_SA(b, h) + aoff + m * 2048 + k * 1024); } while (0)
#define PG8_LDB(dst, b, h) do { _Pragma("unroll") for (int n = 0; n < 2; ++n) _Pragma("unroll") for (int k = 0; k < 2; ++k) dst[n][k] = *(const LAS bf16x8*)(lds + PG8_SB(b, h) + boff + n * 2048 + k * 1024); } while (0)
#define PG8_MMA(ai, bj, At, Bt) do { __builtin_amdgcn_s_setprio(1); _Pragma("unroll") for (int m = 0; m < 4; ++m) _Pragma("unroll") for (int n = 0; n < 2; ++n) _Pragma("unroll") for (int k = 0; k < 2; ++k) \
        acc[ai][bj][m][n] = __builtin_amdgcn_mfma_f32_16x16x32_bf16(Bt[n][k], At[m][k], acc[ai][bj][m][n], 0, 0, 0); __builtin_amdgcn_s_setprio(0); } while (0)
#define PG8_WAIT_V(n) asm volatile("s_waitcnt vmcnt(" #n ")" ::: "memory")
#define PG8_WAIT_L(n) asm volatile("s_waitcnt lgkmcnt(" #n ")" ::: "memory")
#define PG8_BAR __builtin_amdgcn_s_barrier()
#define PG8_SCHED __builtin_amdgcn_sched_barrier(0)
    Unit cur, nxt; int ui = 0;
    if (!S.next(0, cur)) return;
    f32x4 acc[2][2][4][2];
#pragma unroll
    for (int a = 0; a < 2; ++a)
#pragma unroll
        for (int b = 0; b < 2; ++b)
#pragma unroll
            for (int m = 0; m < 4; ++m)
#pragma unroll
                for (int n = 0; n < 2; ++n) acc[a][b][m][n] = (f32x4){0.f, 0.f, 0.f, 0.f};
    bf16x8 At[4][2], B0[2][2], B1[2][2];
    const char* cA = (const char*)g.A + (size_t)cur.pm * tstep; const char* cB = (const char*)g.Bt + (size_t)cur.pn * tstep;
    S.a_ready(cur);
    PG8_STAGE(PG8_SB(0, 0), cB, voffB); PG8_STAGE(PG8_SB(0, 1), cB + hstep, voffB); PG8_STAGE(PG8_SA(0, 0), cA, voffA); PG8_STAGE(PG8_SA(0, 1), cA + hstep, voffA);
    if (wr == 1) PG8_BAR;
    PG8_WAIT_V(2); PG8_BAR;
    PG8_STAGE(PG8_SB(1, 0), cB + kstep, voffB); PG8_STAGE(PG8_SA(1, 0), cA + kstep, voffA); PG8_STAGE(PG8_SB(1, 1), cB + hstep + kstep, voffB);
    PG8_WAIT_V(6); PG8_BAR;
    for (;;) {
        const bool has_next = S.next(ui + 1, nxt);
        const char* nA = has_next ? (const char*)g.A + (size_t)nxt.pm * tstep : cA; const char* nB = has_next ? (const char*)g.Bt + (size_t)nxt.pn * tstep : cB;
        for (int t = 0; t < nt; t += 2) {
            const bool last = (t == nt - 2);
            const char* a1 = cA + (size_t)(t + 1) * kstep;
            const char* a2 = last ? nA : cA + (size_t)(t + 2) * kstep; const char* b2 = last ? nB : cB + (size_t)(t + 2) * kstep;
            const char* a3 = a2 + kstep; const char* b3 = b2 + kstep;
            if (last && has_next) S.a_ready(nxt);
            PG8_LDB(B0, 0, 0); PG8_LDB(B1, 0, 1); PG8_SCHED; PG8_LDA(At, 0, 0); PG8_STAGE(PG8_SA(1, 1), a1 + hstep, voffA);
            PG8_WAIT_V(8); PG8_WAIT_L(0); PG8_BAR; PG8_MMA(0, 0, At, B0); PG8_MMA(0, 1, At, B1); PG8_BAR; PG8_SCHED;
            PG8_LDA(At, 0, 1); PG8_STAGE(PG8_SB(0, 0), b2, voffB); PG8_STAGE(PG8_SB(0, 1), b2 + hstep, voffB); PG8_STAGE(PG8_SA(0, 0), a2, voffA);
            PG8_WAIT_V(8); PG8_WAIT_L(0); PG8_BAR; PG8_MMA(1, 0, At, B0); PG8_MMA(1, 1, At, B1); PG8_BAR; PG8_SCHED;
            PG8_LDB(B0, 1, 0); PG8_LDB(B1, 1, 1); PG8_SCHED; PG8_LDA(At, 1, 0); PG8_STAGE(PG8_SA(0, 1), a2 + hstep, voffA);
            PG8_WAIT_V(8); PG8_WAIT_L(0); PG8_BAR; PG8_MMA(0, 0, At, B0); PG8_MMA(0, 1, At, B1); PG8_BAR; PG8_SCHED;
            PG8_LDA(At, 1, 1); PG8_STAGE(PG8_SB(1, 0), b3, voffB); PG8_STAGE(PG8_SB(1, 1), b3 + hstep, voffB); PG8_STAGE(PG8_SA(1, 0), a3, voffA);
            PG8_WAIT_V(8); PG8_WAIT_L(0); PG8_BAR; PG8_MMA(1, 0, At, B0); PG8_MMA(1, 1, At, B1); PG8_BAR; PG8_SCHED;
        }
        if (wr == 0) PG8_BAR;
        E(acc, cur, wr, wc, fr, fq); S.done(cur);
        if (!has_next) break;
#pragma unroll
        for (int a = 0; a < 2; ++a)
#pragma unroll
            for (int b = 0; b < 2; ++b)
#pragma unroll
                for (int m = 0; m < 4; ++m)
#pragma unroll
                    for (int n = 0; n < 2; ++n) acc[a][b][m][n] = (f32x4){0.f, 0.f, 0.f, 0.f};
        cur = nxt; cA = nA; cB = nB; ++ui;
        if (wr == 1) PG8_BAR;
    }
    PG8_WAIT_V(0);
    PG8_BAR;
#undef PG8_SA
#undef PG8_SB
#undef PG8_STAGE
#undef PG8_LDA
#undef PG8_LDB
#undef PG8_MMA
#undef PG8_WAIT_V
#undef PG8_WAIT_L
#undef PG8_BAR
#undef PG8_SCHED
}
}

namespace att {
constexpr int D = 128, NW = 8, QBLK = 32, KVBLK = 64;
constexpr float THR = 8.f;
constexpr int LDQ = QKV_N, LDK = QKV_N, LDO = DM;
constexpr int NBUF = 3, BUF_V = KVBLK * D * 2, BUF_BYTES = 3 * BUF_V;
constexpr int OFF_WS = NBUF * BUF_BYTES, OFF_TAB = OFF_WS + NW * 64 * 4, ATT_LDS = OFF_TAB + 2048;
#define KSWZ(row, colB) ((row) * 256 + ((colB) ^ (((row) & 15) << 4)))
#define SBAR() __builtin_amdgcn_sched_barrier(0)
__device__ __forceinline__ int crow(int r, int hi) { return (r & 3) + 8 * (r >> 2) + 4 * hi; }

__device__ __forceinline__ void partialSM(f32x16& p0, f32x16& p1, float& m_reg, float& mn, float& alpha, float cb) {
  constexpr float C = LOG2E;
  float pmax = p0[0];
#pragma unroll
  for (int r = 1; r < 16; ++r) pmax = fmaxf(pmax, p0[r]);
#pragma unroll
  for (int r = 0; r < 16; ++r) pmax = fmaxf(pmax, p1[r]);
  { auto rr = __builtin_amdgcn_permlane32_swap(__float_as_uint(pmax), __float_as_uint(pmax), false, false);
    pmax = fmaxf(__uint_as_float(rr[0]), __uint_as_float(rr[1])) + cb; }
  if (__builtin_expect(__all(pmax - m_reg <= THR), 1)) { mn = m_reg; alpha = 1.f; }
  else { mn = fmaxf(m_reg, pmax); alpha = __builtin_amdgcn_exp2f((m_reg - mn) * C); m_reg = mn; }
  float mnC = (cb - mn) * C;
#pragma unroll
  for (int r = 0; r < 16; ++r) p0[r] = fmaf(p0[r], C, mnC);
#pragma unroll
  for (int r = 0; r < 16; ++r) p1[r] = fmaf(p1[r], C, mnC);
#pragma unroll
  for (int r = 0; r < 16; ++r) p0[r] = __builtin_amdgcn_exp2f(p0[r]);
}
__device__ __forceinline__ void finishSM(f32x16& p0, f32x16& p1, float alpha, float& l_reg, bf16x8& pa0, bf16x8& pa1, bf16x8& pa2, bf16x8& pa3) {
#pragma unroll
  for (int r = 0; r < 16; ++r) p1[r] = __builtin_amdgcn_exp2f(p1[r]);
  float ps = 0;
#pragma unroll
  for (int r = 0; r < 16; ++r) ps += p0[r];
#pragma unroll
  for (int r = 0; r < 16; ++r) ps += p1[r];
  { auto rr = __builtin_amdgcn_permlane32_swap(__float_as_uint(ps), __float_as_uint(ps), false, false);
    ps = __uint_as_float(rr[0]) + __uint_as_float(rr[1]); }
  l_reg = l_reg * alpha + ps;
#define PK4(P, BASE, OUT) do { unsigned a0 = cvt_pk_bf16(P[BASE + 0], P[BASE + 1]), a1 = cvt_pk_bf16(P[BASE + 2], P[BASE + 3]);   \
    unsigned b0 = cvt_pk_bf16(P[BASE + 4], P[BASE + 5]), b1 = cvt_pk_bf16(P[BASE + 6], P[BASE + 7]);                              \
    auto r0 = __builtin_amdgcn_permlane32_swap(a0, b0, false, false); auto r1 = __builtin_amdgcn_permlane32_swap(a1, b1, false, false); \
    u32x4 w = {r0[0], r1[0], r0[1], r1[1]}; OUT = *reinterpret_cast<bf16x8*>(&w); } while (0)
  PK4(p0, 0, pa0); PK4(p0, 8, pa1); PK4(p1, 0, pa2); PK4(p1, 8, pa3);
#undef PK4
}
__device__ __forceinline__ float qkt(f32x16& p0, f32x16& p1, const char* Ks, const bf16x8* qr, int r32, int hi, const LAS float* tab, int rel0, int farmode) {
  float cb = 0.f;
  if (farmode != 0) { cb = tab[farmode < 0 ? 0 : 384]; p0 = f32x16{}; p1 = f32x16{};
  } else {
    const LAS float* tb = tab + (rel0 + 192 + 4 * hi);
#pragma unroll
    for (int r = 0; r < 16; ++r) { p0[r] = tb[(r & 3) + 8 * (r >> 2)]; p1[r] = tb[32 + (r & 3) + 8 * (r >> 2)]; }
  }
#pragma unroll
  for (int d0 = 0; d0 < 8; ++d0) { int cb = (d0 * 16 + hi * 8) * 2;
    bf16x8 b0 = *reinterpret_cast<const bf16x8*>(Ks + KSWZ(r32, cb));
    bf16x8 b1 = *reinterpret_cast<const bf16x8*>(Ks + KSWZ(32 + r32, cb));
    p0 = __builtin_amdgcn_mfma_f32_32x32x16_bf16(b0, qr[d0], p0, 0, 0, 0);
    p1 = __builtin_amdgcn_mfma_f32_32x32x16_bf16(b1, qr[d0], p1, 0, 0, 0); }
  return cb;
}
__device__ __forceinline__ int v_st(int k, int c) { const int kk = (k & ~0xC) | ((k & 4) << 1) | ((k & 8) >> 1); return ((kk >> 3) * 4 + (c >> 5)) * 512 + ((kk & 7) * 32 + (c & 31)) * 2; }
__device__ __forceinline__ int v_rd_base(int lane) { return ((lane & 3) << 3) | (((lane >> 2) & 3) << 6) | (((lane >> 4) & 1) << 5) | (((lane >> 5) & 1) << 8); }
constexpr int v_rd_off(int d0, int ks, int half) { return d0 * 512 + ks * 4096 + half * 2048; }
template <int OFF> __device__ __forceinline__ s16x4 tr_read(int vb) {
  s16x4 r; asm volatile("ds_read_b64_tr_b16 %0, %1 offset:%2" : "=&v"(r) : "v"(vb), "i"(OFF) : "memory"); return r;
}
template <int D0> __device__ __forceinline__ void pv_one(f32x16& od, int vb, bf16x8 pa0, bf16x8 pa1, bf16x8 pa2, bf16x8 pa3) {
  const s16x4 l0 = tr_read<v_rd_off(D0, 0, 0)>(vb), h0 = tr_read<v_rd_off(D0, 0, 1)>(vb), l1 = tr_read<v_rd_off(D0, 1, 0)>(vb), h1 = tr_read<v_rd_off(D0, 1, 1)>(vb);
  const s16x4 l2 = tr_read<v_rd_off(D0, 2, 0)>(vb), h2 = tr_read<v_rd_off(D0, 2, 1)>(vb), l3 = tr_read<v_rd_off(D0, 3, 0)>(vb), h3 = tr_read<v_rd_off(D0, 3, 1)>(vb);
  asm volatile("s_waitcnt lgkmcnt(0)" ::: "memory"); SBAR();
#define PK(L, H) (bf16x8){L[0], L[1], L[2], L[3], H[0], H[1], H[2], H[3]}
  od = __builtin_amdgcn_mfma_f32_32x32x16_bf16(pa0, PK(l0, h0), od, 0, 0, 0);
  od = __builtin_amdgcn_mfma_f32_32x32x16_bf16(pa1, PK(l1, h1), od, 0, 0, 0);
  od = __builtin_amdgcn_mfma_f32_32x32x16_bf16(pa2, PK(l2, h2), od, 0, 0, 0);
  od = __builtin_amdgcn_mfma_f32_32x32x16_bf16(pa3, PK(l3, h3), od, 0, 0, 0);
#undef PK
}
__device__ __forceinline__ void pv_d0(f32x16* o, int vb, bf16x8 pa0, bf16x8 pa1, bf16x8 pa2, bf16x8 pa3) {
  pv_one<0>(o[0], vb, pa0, pa1, pa2, pa3); pv_one<1>(o[1], vb, pa0, pa1, pa2, pa3); pv_one<2>(o[2], vb, pa0, pa1, pa2, pa3); pv_one<3>(o[3], vb, pa0, pa1, pa2, pa3);
}
constexpr int v_off8(int d, int ks, int half) { return (d >> 2) * BUF_V + (d & 3) * 512 + ks * 4096 + half * 2048; }
#define PV_LOAD(S, DD) do { S[0] = tr_read<v_off8(DD, 0, 0)>(vb); S[1] = tr_read<v_off8(DD, 0, 1)>(vb); S[2] = tr_read<v_off8(DD, 1, 0)>(vb); S[3] = tr_read<v_off8(DD, 1, 1)>(vb); \
    S[4] = tr_read<v_off8(DD, 2, 0)>(vb); S[5] = tr_read<v_off8(DD, 2, 1)>(vb); S[6] = tr_read<v_off8(DD, 3, 0)>(vb); S[7] = tr_read<v_off8(DD, 3, 1)>(vb); } while (0)
#define PV_PK(L, H) (bf16x8){L[0], L[1], L[2], L[3], H[0], H[1], H[2], H[3]}
#define PV_MMA(OD, S) do { OD = __builtin_amdgcn_mfma_f32_32x32x16_bf16(pa0, PV_PK(S[0], S[1]), OD, 0, 0, 0); OD = __builtin_amdgcn_mfma_f32_32x32x16_bf16(pa1, PV_PK(S[2], S[3]), OD, 0, 0, 0); \
    OD = __builtin_amdgcn_mfma_f32_32x32x16_bf16(pa2, PV_PK(S[4], S[5]), OD, 0, 0, 0); OD = __builtin_amdgcn_mfma_f32_32x32x16_bf16(pa3, PV_PK(S[6], S[7]), OD, 0, 0, 0); } while (0)
#define PV_W8() do { asm volatile("s_waitcnt lgkmcnt(8)" ::: "memory"); SBAR(); } while (0)
#define PV_W0() do { asm volatile("s_waitcnt lgkmcnt(0)" ::: "memory"); SBAR(); } while (0)
__device__ __forceinline__ void pv8(f32x16* o, int vb, bf16x8 pa0, bf16x8 pa1, bf16x8 pa2, bf16x8 pa3) {
  s16x4 A[8], B[8];
  PV_LOAD(A, 0);
  PV_LOAD(B, 1); PV_W8(); PV_MMA(o[0], A); SBAR();
  PV_LOAD(A, 2); PV_W8(); PV_MMA(o[1], B); SBAR();
  PV_LOAD(B, 3); PV_W8(); PV_MMA(o[2], A); SBAR();
  PV_LOAD(A, 4); PV_W8(); PV_MMA(o[3], B); SBAR();
  PV_LOAD(B, 5); PV_W8(); PV_MMA(o[4], A); SBAR();
  PV_LOAD(A, 6); PV_W8(); PV_MMA(o[5], B); SBAR();
  PV_LOAD(B, 7); PV_W8(); PV_MMA(o[6], A); SBAR();
  PV_W0(); PV_MMA(o[7], B);
}

__device__ __forceinline__ void attn_pass(const bf16_t* __restrict__ Qb, const bf16_t* __restrict__ Kh, const bf16_t* __restrict__ Vh,
                                          float* Ob, int mode, float lam, int qpos0, int seq, char* lds, const int wv) {
  const int tid = otid(wv), wid = __builtin_amdgcn_readfirstlane(tid >> 6), lane = tid & 63, r32 = lane & 31, hi = lane >> 5;
  float* ws = (float*)(lds + OFF_WS) + wid * 64; float* li_l = ws; float* al_l = ws + 32;
  const LAS float* tab = (const LAS float*)(LAS char*)(lds + OFF_TAB);
  float m_reg = -1e30f, l_reg = 0; f32x16 o[8] = {}; bf16x8 qr[8];
  const bf16_t* Qw = Qb + (long)(wid * QBLK + r32) * LDQ + hi * 8;
#pragma unroll
  for (int d0 = 0; d0 < 8; ++d0) qr[d0] = *reinterpret_cast<const bf16x8*>(Qw + d0 * 16);
  const int vb0 = (int)(uintptr_t)(LAS char*)lds + BUF_V + v_rd_base(lane);
  const int qw0 = qpos0 + wid * QBLK, qlane = qw0 + r32;
  unsigned koff[2], voff[2];
#pragma unroll
  for (int i = 0; i < 2; ++i) { const int p = i * 512 + wid * 64 + lane;
    { const int row = p >> 4, g = p & 15; koff[i] = (unsigned)(row * LDK * 2 + ((g ^ (row & 15)) << 4)); }
    { const int kk = ((p >> 7) << 3) | ((p >> 2) & 7), c = ((p >> 5) & 3) * 32 + (p & 3) * 8; const int k = (kk & ~0xC) | ((kk & 4) << 1) | ((kk & 8) >> 1); voff[i] = (unsigned)(k * LDK * 2 + c * 2); } }
  LAS unsigned char* ldsw = (LAS unsigned char*)lds + wid * 1024;
#define DMA(tile, boff) do { const char* kg_ = (const char*)Kh + (size_t)(tile) * (KVBLK * LDK * 2); const char* vg_ = (const char*)Vh + (size_t)(tile) * (KVBLK * LDK * 2); \
    __builtin_amdgcn_global_load_lds((const unsigned*)(kg_ + koff[0]), (LAS unsigned*)(ldsw + (boff)), 16, 0, 0);                  \
    __builtin_amdgcn_global_load_lds((const unsigned*)(kg_ + koff[1]), (LAS unsigned*)(ldsw + (boff) + 8192), 16, 0, 0);           \
    __builtin_amdgcn_global_load_lds((const unsigned*)(vg_ + voff[0]), (LAS unsigned*)(ldsw + (boff) + BUF_V), 16, 0, 0);          \
    __builtin_amdgcn_global_load_lds((const unsigned*)(vg_ + voff[1]), (LAS unsigned*)(ldsw + (boff) + BUF_V + 8192), 16, 0, 0);   \
    __builtin_amdgcn_global_load_lds((const unsigned*)(vg_ + 256 + voff[0]), (LAS unsigned*)(ldsw + (boff) + 2 * BUF_V), 16, 0, 0);        \
    __builtin_amdgcn_global_load_lds((const unsigned*)(vg_ + 256 + voff[1]), (LAS unsigned*)(ldsw + (boff) + 2 * BUF_V + 8192), 16, 0, 0); } while (0)
#define STEP_SYNC() do { asm volatile("s_waitcnt vmcnt(0) lgkmcnt(0)" ::: "memory"); __builtin_amdgcn_s_barrier(); asm volatile("" ::: "memory"); } while (0)
#define RESC(a) do { if (__any((a) < 1.f)) { if (hi == 0) al_l[r32] = (a); asm volatile("s_waitcnt lgkmcnt(0)" ::: "memory"); \
    _Pragma("unroll") for (int d = 0; d < 8; ++d) _Pragma("unroll") for (int r = 0; r < 16; ++r) o[d][r] *= al_l[crow(r, hi)]; } } while (0)
#define FARMODE(k0) (((k0) + 63 - qw0 <= -91) ? -1 : (((k0) - (qw0 + 31) >= 91) ? 1 : 0))
  f32x16 p0, p1; float mn, al; bf16x8 pa0, pa1, pa2, pa3; const int NT = seq / KVBLK;
  int bprev = 0, bcur = 0, bnext = BUF_BYTES;
#define ROT() do { bprev = bcur; bcur = bnext; bnext = (bnext + BUF_BYTES == NBUF * BUF_BYTES) ? 0 : bnext + BUF_BYTES; } while (0)
  DMA(0, 0); STEP_SYNC();
  if (wid < 4) {
#pragma unroll 1
    for (int j = 0; j < NT; ++j) {
      if (j + 1 < NT) DMA(j + 1, bnext);
      SBAR();
      __builtin_amdgcn_s_setprio(1);
      float cb; { const int k0 = j * KVBLK; cb = qkt(p0, p1, lds + bcur, qr, r32, hi, tab, k0 - qlane, FARMODE(k0)); }
      __builtin_amdgcn_s_setprio(0);
      partialSM(p0, p1, m_reg, mn, al, cb);
      RESC(al);
      finishSM(p0, p1, al, l_reg, pa0, pa1, pa2, pa3); SBAR();
      __builtin_amdgcn_s_setprio(1);
      pv8(o, vb0 + bcur, pa0, pa1, pa2, pa3);
      __builtin_amdgcn_s_setprio(0);
      STEP_SYNC();
      ROT();
    }
  } else {
    DMA(1, bnext);
    SBAR();
    const float cb0 = qkt(p0, p1, lds + bcur, qr, r32, hi, tab, 0 - qlane, FARMODE(0));
    partialSM(p0, p1, m_reg, mn, al, cb0);
    finishSM(p0, p1, al, l_reg, pa0, pa1, pa2, pa3); SBAR();
    STEP_SYNC();
    ROT();
#pragma unroll 1
    for (int j = 1; j < NT; ++j) {
      if (j + 1 < NT) DMA(j + 1, bnext);
      SBAR();
      __builtin_amdgcn_s_setprio(1);
      pv8(o, vb0 + bprev, pa0, pa1, pa2, pa3);
      SBAR();
      float cb; { const int k0 = j * KVBLK; cb = qkt(p0, p1, lds + bcur, qr, r32, hi, tab, k0 - qlane, FARMODE(k0)); }
      __builtin_amdgcn_s_setprio(0);
      partialSM(p0, p1, m_reg, mn, al, cb);
      RESC(al);
      finishSM(p0, p1, al, l_reg, pa0, pa1, pa2, pa3); SBAR();
      STEP_SYNC();
      ROT();
    }
    pv8(o, vb0 + bprev, pa0, pa1, pa2, pa3);
  }
#undef ROT
  if (hi == 0) li_l[r32] = l_reg; asm volatile("s_waitcnt lgkmcnt(0)" ::: "memory");
  float rli[16];
#pragma unroll
  for (int r = 0; r < 16; ++r) rli[r] = __builtin_amdgcn_rcpf(li_l[crow(r, hi)]);
  __syncthreads();
  float* stg = (float*)(lds + wid * 16384);
  float* Ow = Ob + (long)(wid * QBLK) * LDO;
  const int srow = lane >> 5, sc4 = (lane & 31) * 4;
#pragma unroll
  for (int half = 0; half < 2; ++half) {
#pragma unroll
    for (int d = 0; d < 4; ++d)
#pragma unroll
      for (int r = 0; r < 16; ++r) stg[crow(r, hi) * 128 + d * 32 + r32] = o[half * 4 + d][r] * rli[r];
    asm volatile("s_waitcnt lgkmcnt(0)" ::: "memory");
    if (mode == 0) {
#pragma unroll
      for (int k = 0; k < 16; ++k) { const int row = 2 * k + srow; const f32x4 v = *(const f32x4*)(stg + row * 128 + sc4);
        *(f32x4*)(Ow + (long)row * LDO + half * 128 + sc4) = v; }
    } else {
#pragma unroll
      for (int k = 0; k < 16; ++k) { const int row = 2 * k + srow; const f32x4 v = *(const f32x4*)(stg + row * 128 + sc4);
        f32x4* gp = (f32x4*)(Ow + (long)row * LDO + half * 128 + sc4); *gp = *gp - lam * v; }
    }
    asm volatile("s_waitcnt lgkmcnt(0)" ::: "memory");
  }
#undef DMA
#undef STEP_SYNC
#undef RESC
#undef FARMODE
}
}

struct Args { const float* in[19]; float* out; unsigned char* ws; int lo, hi, coop, pad; };
typedef const __attribute__((address_space(4))) Args* KArgs;
__device__ __forceinline__ KArgs kargs() { auto p = __builtin_amdgcn_kernarg_segment_ptr(); asm volatile("" : "+s"(p)); return (KArgs)p; }

struct TItem { const float* W; bf16_t* WT; int K, N, k0, n0, drow0; };
__device__ __forceinline__ void tile_load(const TItem& t, f32x4 (&v)[8], int lane) {
#pragma unroll
    for (int i = 0; i < 8; ++i) { const int kk = 8 * i + (lane >> 3); v[i] = *(const f32x4*)(t.W + (size_t)(t.k0 + kk) * t.N + t.n0 + 4 * (lane & 7)); }
}
__device__ __forceinline__ void tile_store(const TItem& t, const f32x4 (&v)[8], LAS float* scr, int lane) {
#pragma unroll
    for (int i = 0; i < 8; ++i) { const int kk = 8 * i + (lane >> 3); LAS float* s = scr + kk * 33 + 4 * (lane & 7); s[0] = v[i][0]; s[1] = v[i][1]; s[2] = v[i][2]; s[3] = v[i][3]; }
    asm volatile("s_waitcnt lgkmcnt(0)" ::: "memory");
    const int c = lane & 7;
#pragma unroll
    for (int j = 0; j < 4; ++j) { const int n = (lane >> 3) + 8 * j; const LAS float* s = scr + (8 * c) * 33 + n;
        u32x4 o; o.x = cvt_pk_bf16(s[0 * 33], s[1 * 33]); o.y = cvt_pk_bf16(s[2 * 33], s[3 * 33]); o.z = cvt_pk_bf16(s[4 * 33], s[5 * 33]); o.w = cvt_pk_bf16(s[6 * 33], s[7 * 33]);
        *(u32x4*)(t.WT + (size_t)(t.drow0 + n) * t.K + t.k0 + 8 * c) = o; }
    asm volatile("s_waitcnt lgkmcnt(0)" ::: "memory");
}

template <int NR> __device__ __forceinline__ void norm_phase_t(const bf16_t* mbuf, const float* ga, const float* xin, float* xout, const float* gb, bf16_t* hout, int gw, int NGW, int lane) {
    for (int row = gw; row < M_TOK; row += NR * NGW) {
        f32x4 xv[NR][8]; u32x4 mv[NR][4];
#pragma unroll
        for (int rr = 0; rr < NR; ++rr) { const int r = row + rr * NGW; if (r < M_TOK) {
            const float* xr = xin + (size_t)r * DM + 8 * lane;
#pragma unroll
            for (int j = 0; j < 4; ++j) { xv[rr][2 * j] = __builtin_nontemporal_load((const f32x4*)(xr + 512 * j)); xv[rr][2 * j + 1] = __builtin_nontemporal_load((const f32x4*)(xr + 512 * j + 4)); }
            if (mbuf) {
#pragma unroll
                for (int j = 0; j < 4; ++j) mv[rr][j] = __builtin_nontemporal_load((const u32x4*)(mbuf + (size_t)r * DM + 8 * lane + 512 * j)); } } }
#pragma unroll
        for (int rr = 0; rr < NR; ++rr) { const int r = row + rr * NGW; if (r < M_TOK) {
            if (mbuf) {
                float ss = 0.f;
#pragma unroll
                for (int j = 0; j < 4; ++j)
#pragma unroll
                    for (int k = 0; k < 4; ++k) { const float lo = bf_lo(mv[rr][j][k]), hi = bf_hi(mv[rr][j][k]); ss += lo * lo + hi * hi; }
                const float rs = 1.0f / sqrtf(wave_sum(ss) * (1.0f / DM) + EPS);
                float* xo = xout + (size_t)r * DM + 8 * lane;
#pragma unroll
                for (int j = 0; j < 4; ++j) { const f32x4 g0 = *(const f32x4*)(ga + 8 * lane + 512 * j), g1 = *(const f32x4*)(ga + 8 * lane + 512 * j + 4);
                    const f32x4 m0 = {bf_lo(mv[rr][j][0]), bf_hi(mv[rr][j][0]), bf_lo(mv[rr][j][1]), bf_hi(mv[rr][j][1])}, m1 = {bf_lo(mv[rr][j][2]), bf_hi(mv[rr][j][2]), bf_lo(mv[rr][j][3]), bf_hi(mv[rr][j][3])};
                    xv[rr][2 * j] = xv[rr][2 * j] + m0 * rs * g0; xv[rr][2 * j + 1] = xv[rr][2 * j + 1] + m1 * rs * g1;
                    __builtin_nontemporal_store(xv[rr][2 * j], (f32x4*)(xo + 512 * j)); __builtin_nontemporal_store(xv[rr][2 * j + 1], (f32x4*)(xo + 512 * j + 4)); }
            }
            if (hout) {
                float ss = 0.f;
#pragma unroll
                for (int j = 0; j < 8; ++j) ss += (xv[rr][j][0] * xv[rr][j][0] + xv[rr][j][1] * xv[rr][j][1]) + (xv[rr][j][2] * xv[rr][j][2] + xv[rr][j][3] * xv[rr][j][3]);
                const float rs = 1.0f / sqrtf(wave_sum(ss) * (1.0f / DM) + EPS);
                bf16_t* ho = hout + (size_t)r * DM + 8 * lane;
#pragma unroll
                for (int j = 0; j < 4; ++j) { const f32x4 g0 = *(const f32x4*)(gb + 8 * lane + 512 * j), g1 = *(const f32x4*)(gb + 8 * lane + 512 * j + 4);
                    const f32x4 y0 = xv[rr][2 * j] * rs * g0, y1 = xv[rr][2 * j + 1] * rs * g1;
                    u32x4 w; w.x = cvt_pk_bf16(y0[0], y0[1]); w.y = cvt_pk_bf16(y0[2], y0[3]); w.z = cvt_pk_bf16(y1[0], y1[1]); w.w = cvt_pk_bf16(y1[2], y1[3]);
                    *(u32x4*)(ho + 512 * j) = w; }
            } } }
    }
}

__device__ __forceinline__ void norm_phase(const bf16_t* mbuf, const float* ga, const float* xin, float* xout, const float* gb, bf16_t* hout, int gw, int NGW, int lane) {
    norm_phase_t<4>(mbuf, ga, xin, xout, gb, hout, gw, NGW, lane);
}
__device__ __forceinline__ TItem prep_decode(int it) {
    KArgs ap = kargs(); unsigned char* ws = ap->ws;
    constexpr int I_IN = 32 * 128, I_OAB = 32 * 64, I_QKV = 32 * 192, I_OC = 32 * 64, I_G = 32 * 176, I_D = 88 * 64;
    int r = it; TItem t; int mode;
    if (r < 2 * I_IN) { const int e = r / I_IN; r -= e * I_IN; t.W = ap->in[2] + (size_t)e * DM * IN_AB; t.WT = (bf16_t*)(ws + WS_WIN + e * SZ_WIN); t.K = DM; t.N = IN_AB; mode = 1; }
    else { r -= 2 * I_IN;
    if (r < 2 * I_OAB) { const int e = r / I_OAB; r -= e * I_OAB; t.W = ap->in[10] + (size_t)e * DM * DM; t.WT = (bf16_t*)(ws + WS_WOAB + e * SZ_WOAB); t.K = DM; t.N = DM; mode = 0; }
    else { r -= 2 * I_OAB;
    if (r < 2 * I_QKV) { const int e = r / I_QKV; r -= e * I_QKV; t.W = ap->in[11] + (size_t)e * DM * QKV_N; t.WT = (bf16_t*)(ws + WS_WQKV + e * SZ_WQKV); t.K = DM; t.N = QKV_N; mode = 0; }
    else { r -= 2 * I_QKV;
    if (r < 2 * I_OC) { const int e = r / I_OC; r -= e * I_OC; t.W = ap->in[14] + (size_t)e * DM * DM; t.WT = (bf16_t*)(ws + WS_WOC + e * SZ_WOC); t.K = DM; t.N = DM; mode = 0; }
    else { r -= 2 * I_OC;
        const int per = 2 * I_G + I_D; const int l = r / per; r -= l * per;
        if (r < I_G) { t.W = ap->in[16] + (size_t)l * DM * DFF; t.WT = (bf16_t*)(ws + WS_WGU + l * SZ_WGU); t.K = DM; t.N = DFF; mode = 2; }
        else if (r < 2 * I_G) { r -= I_G; t.W = ap->in[17] + (size_t)l * DM * DFF; t.WT = (bf16_t*)(ws + WS_WGU + l * SZ_WGU); t.K = DM; t.N = DFF; mode = 3; }
        else { r -= 2 * I_G; t.W = ap->in[18] + (size_t)l * DFF * DM; t.WT = (bf16_t*)(ws + WS_WDN + l * SZ_WDN); t.K = DFF; t.N = DM; mode = 0; }
    } } } }
    const int nblk = t.N / 32, kb = r / nblk, nb = r % nblk; t.k0 = 64 * kb; t.n0 = 32 * nb;
    const int n0 = t.n0; int drow0 = n0;
    if (mode == 1) { if (n0 < 1024) drow0 = (n0 >> 7) * 256 + (n0 & 127); else if (n0 < 2048) { const int ch = n0 - 1024; drow0 = (ch >> 7) * 256 + 128 + (ch & 127); } }
    else if (mode == 2) drow0 = (n0 >> 7) * 256 + (n0 & 127);
    else if (mode == 3) drow0 = (n0 >> 7) * 256 + 128 + (n0 & 127);
    t.drow0 = drow0; return t;
}
__device__ __forceinline__ void prep_phase(unsigned char* lds, int vcu, int G, const int wv) {
    KArgs ap = kargs();
    const int tid = otid(wv), wid = __builtin_amdgcn_readfirstlane(tid >> 6), lane = tid & 63;
    LAS float* scr = (LAS float*)(LAS unsigned char*)lds + wid * (64 * 33);
    const int gw = vcu * 8 + wid, NGW = G * 8;
    constexpr int I_IN = 32 * 128, I_OAB = 32 * 64, I_QKV = 32 * 192, I_OC = 32 * 64, I_G = 32 * 176, I_D = 88 * 64;
    constexpr int NITEMS = 2 * I_IN + 2 * I_OAB + 2 * I_QKV + 2 * I_OC + 4 * (2 * I_G + I_D);
    unsigned char* ws = ap->ws;
    int it = gw;
    if (it < NITEMS) {
        TItem cur = prep_decode(it); f32x4 v[8]; tile_load(cur, v, lane);
        for (;;) {
            const int nit = it + NGW; const bool has = nit < NITEMS; TItem nx = cur; f32x4 vn[8];
            if (has) { nx = prep_decode(nit); tile_load(nx, vn, lane); }
            tile_store(cur, v, scr, lane);
            if (!has) break;
            cur = nx; it = nit;
#pragma unroll
            for (int i = 0; i < 8; ++i) v[i] = vn[i];
        }
    }
    norm_phase(nullptr, nullptr, ap->in[0], nullptr, ap->in[1], (bf16_t*)(ws + WS_H), gw, NGW, lane);
}

__device__ __forceinline__ void conv_item(int it, const bf16_t* AG, const float* dw, const float* cg_, const float* cb_, bf16_t* CAT, unsigned char* lds, const int wv) {
    const int tid = otid(wv), wid = __builtin_amdgcn_readfirstlane(tid >> 6), lane = tid & 63;
    const int t0 = it * 32, b = t0 >> 12, s0 = t0 & 4095;
    LAS unsigned char* X = (LAS unsigned char*)lds;
    LAS f32x2* red = (LAS f32x2*)(X + 62 * 2048);
    LAS f32x2* stat = red + 256;
    __syncthreads();
#pragma unroll
    for (int p = 0; p < 16; ++p) { const int r = p * 4 + (tid >> 7);
        if (r < 62) { const int sp = s0 - 15 + r; u32x4 val = {0u, 0u, 0u, 0u};
            if (sp >= 0 && sp < SEQ) val = *(const u32x4*)(AG + ((size_t)(b * SEQ + sp)) * 1024 + 8 * (tid & 127));
            *(LAS u32x4*)(X + r * 2048 + 16 * (tid & 127)) = val; } }
    __syncthreads();
    f32x2 wt[CONV_W];
#pragma unroll
    for (int j = 0; j < CONV_W; ++j) wt[j] = *(const f32x2*)(dw + j * 1024 + 2 * tid);
    f32x2 accv[32];
#pragma unroll
    for (int tt = 0; tt < 32; ++tt) accv[tt] = (f32x2){0.f, 0.f};
    const LAS unsigned* X32 = (const LAS unsigned*)X;
#pragma unroll
    for (int r = 0; r < 62; ++r) {
        const unsigned v = X32[r * 512 + tid]; const f32x2 xf = {bf_lo(v), bf_hi(v)};
#pragma unroll
        for (int tt = (r > 30 ? r - 30 : 0); tt <= (r < 31 ? r : 31); ++tt) accv[tt] = accv[tt] + xf * wt[r - tt];
    }
    float acc[32][2];
#pragma unroll
    for (int tt = 0; tt < 32; ++tt) { acc[tt][0] = accv[tt].x; acc[tt][1] = accv[tt].y; }
#pragma unroll
    for (int tt = 0; tt < 32; ++tt) {
        float s1 = acc[tt][0] + acc[tt][1], s2 = acc[tt][0] * acc[tt][0] + acc[tt][1] * acc[tt][1];
        s1 = wave_sum(s1); s2 = wave_sum(s2);
        if (lane == 0) red[tt * 8 + wid] = (f32x2){s1, s2};
    }
    __syncthreads();
    if (tid < 32) { float s1 = 0.f, s2 = 0.f;
#pragma unroll
        for (int w = 0; w < 8; ++w) { const f32x2 v = red[tid * 8 + w]; s1 += v.x; s2 += v.y; }
        const float mean = s1 * (1.0f / 1024.0f); float var = s2 * (1.0f / 1024.0f) - mean * mean; var = var < 0.f ? 0.f : var;
        stat[tid] = (f32x2){mean, 1.0f / sqrtf(var + EPS)}; }
    __syncthreads();
    const f32x2 g = *(const f32x2*)(cg_ + 2 * tid), bb = *(const f32x2*)(cb_ + 2 * tid);
#pragma unroll
    for (int tt = 0; tt < 32; ++tt) { const f32x2 st = stat[tt];
        float y0 = (acc[tt][0] - st.x) * st.y * g.x + bb.x, y1 = (acc[tt][1] - st.x) * st.y * g.y + bb.y;
        y0 = y0 * sigmoid_f(y0); y1 = y1 * sigmoid_f(y1);
        ((LAS unsigned*)X)[tt * 512 + tid] = cvt_pk_bf16(y0, y1); }
    __syncthreads();
#pragma unroll
    for (int j = 0; j < 8; ++j) { const int c = tid + 512 * j, row = c >> 7, col16 = c & 127;
        const u32x4 v = *(const LAS u32x4*)(X + row * 2048 + col16 * 16);
        *(u32x4*)(CAT + (size_t)(t0 + row) * DM + col16 * 8) = v; }
}

__device__ __forceinline__ void sgu_item(int it, const bf16_t* GV, const bf16_t* ZU, const float* sg_, const float* sb_, const float* wsp, const float* bsp, bf16_t* CAT, unsigned char* lds, const int wv) {
    const int tid = otid(wv), wid = __builtin_amdgcn_readfirstlane(tid >> 6), lane = tid & 63;
    const int chunk = it >> 3, g = it & 7, tok0 = chunk * 128;
    LAS unsigned char* ZT = (LAS unsigned char*)lds;
    __syncthreads();
    {
        float mean[16], rstd[16];
#pragma unroll
        for (int i = 0; i < 16; ++i) { const bf16_t* row = GV + (size_t)(tok0 + 16 * wid + i) * 1024;
            const u32x4 a = *(const u32x4*)(row + 8 * lane), c = *(const u32x4*)(row + 512 + 8 * lane);
            float v[16];
#pragma unroll
            for (int k = 0; k < 4; ++k) { v[2 * k] = bf_lo(a[k]); v[2 * k + 1] = bf_hi(a[k]); v[8 + 2 * k] = bf_lo(c[k]); v[8 + 2 * k + 1] = bf_hi(c[k]); }
            float s = 0.f;
#pragma unroll
            for (int k = 0; k < 16; ++k) s += v[k];
            const float mu = wave_sum(s) * (1.0f / 1024.0f); float q = 0.f;
#pragma unroll
            for (int k = 0; k < 16; ++k) { const float d = v[k] - mu; q += d * d; }
            mean[i] = mu; rstd[i] = 1.0f / sqrtf(wave_sum(q) * (1.0f / 1024.0f) + EPS); }
        const int c0 = g * 128 + 2 * lane;
        const f32x2 sgv = *(const f32x2*)(sg_ + c0), sbv = *(const f32x2*)(sb_ + c0);
        float z0[16], z1[16];
#pragma unroll
        for (int i = 0; i < 16; ++i) { const unsigned v = *(const unsigned*)(GV + (size_t)(tok0 + 16 * wid + i) * 1024 + c0);
            z0[i] = (bf_lo(v) - mean[i]) * rstd[i] * sgv.x + sbv.x; z1[i] = (bf_hi(v) - mean[i]) * rstd[i] * sgv.y + sbv.y; }
        u32x4 w0a, w0b, w1a, w1b;
        w0a.x = cvt_pk_bf16(z0[0], z0[1]); w0a.y = cvt_pk_bf16(z0[2], z0[3]); w0a.z = cvt_pk_bf16(z0[4], z0[5]); w0a.w = cvt_pk_bf16(z0[6], z0[7]);
        w0b.x = cvt_pk_bf16(z0[8], z0[9]); w0b.y = cvt_pk_bf16(z0[10], z0[11]); w0b.z = cvt_pk_bf16(z0[12], z0[13]); w0b.w = cvt_pk_bf16(z0[14], z0[15]);
        w1a.x = cvt_pk_bf16(z1[0], z1[1]); w1a.y = cvt_pk_bf16(z1[2], z1[3]); w1a.z = cvt_pk_bf16(z1[4], z1[5]); w1a.w = cvt_pk_bf16(z1[6], z1[7]);
        w1b.x = cvt_pk_bf16(z1[8], z1[9]); w1b.y = cvt_pk_bf16(z1[10], z1[11]); w1b.z = cvt_pk_bf16(z1[12], z1[13]); w1b.w = cvt_pk_bf16(z1[14], z1[15]);
        LAS unsigned char* r0 = ZT + (2 * lane) * 272 + 32 * wid;
        *(LAS u32x4*)(r0) = w0a; *(LAS u32x4*)(r0 + 16) = w0b; *(LAS u32x4*)(r0 + 272) = w1a; *(LAS u32x4*)(r0 + 272 + 16) = w1b;
    }
    __syncthreads();
    const int pl = lane & 15, kg = lane >> 4, p = 16 * wid + pl;
    bf16x8 Y[4];
#pragma unroll
    for (int ks = 0; ks < 4; ++ks) { const float* wp = wsp + ((size_t)g * 128 + p) * 128 + 32 * ks + 8 * kg;
        const f32x4 a = *(const f32x4*)wp, c = *(const f32x4*)(wp + 4);
        u32x4 w; w.x = cvt_pk_bf16(a[0], a[1]); w.y = cvt_pk_bf16(a[2], a[3]); w.z = cvt_pk_bf16(c[0], c[1]); w.w = cvt_pk_bf16(c[2], c[3]);
        Y[ks] = *reinterpret_cast<bf16x8*>(&w); }
    f32x4 acc[8];
#pragma unroll
    for (int ct = 0; ct < 8; ++ct) { acc[ct] = (f32x4){0.f, 0.f, 0.f, 0.f};
#pragma unroll
        for (int ks = 0; ks < 4; ++ks) { const bf16x8 X = *(const LAS bf16x8*)(ZT + (16 * ct + pl) * 272 + 64 * ks + 16 * kg);
            acc[ct] = __builtin_amdgcn_mfma_f32_16x16x32_bf16(X, Y[ks], acc[ct], 0, 0, 0); } }
    const float bs = bsp[g * 128 + p]; const size_t tok = (size_t)(tok0 + p);
#pragma unroll
    for (int ct = 0; ct < 8; ++ct) { const int c = g * 128 + 16 * ct + 4 * kg;
        const u32x2 zu = *(const u32x2*)(ZU + tok * 1024 + c);
        const float o0 = bf_lo(zu.x) * (acc[ct][0] + bs), o1 = bf_hi(zu.x) * (acc[ct][1] + bs), o2 = bf_lo(zu.y) * (acc[ct][2] + bs), o3 = bf_hi(zu.y) * (acc[ct][3] + bs);
        u32x2 w; w.x = cvt_pk_bf16(o0, o1); w.y = cvt_pk_bf16(o2, o3);
        *(u32x2*)(CAT + tok * DM + 1024 + c) = w; }
}

__device__ __forceinline__ int t5_bucket(int rel) {
    const int n = rel < 0 ? -rel : rel; int v;
    if (n < 8) v = n; else if (n < 12) v = 8; else if (n < 16) v = 9; else if (n < 23) v = 10; else if (n < 32) v = 11; else if (n < 46) v = 12; else if (n < 64) v = 13; else if (n < 91) v = 14; else v = 15;
    return (rel > 0 ? 16 : 0) + v;
}

__device__ __forceinline__ void attn_item(int it, int layer, const bf16_t* QKV, float* SCR, bf16_t* OB, unsigned char* lds, const int wv) {
    const int tid = otid(wv), wid = __builtin_amdgcn_readfirstlane(tid >> 6), lane = tid & 63;
    const int o = layer >> 1;
    const int b = it >> 7, h = (it >> 4) & 7, qb = it & 15;
    const float lambda_init = 0.8f - 0.6f * expf(-0.3f * (float)layer);
    float lam;
    { const float* lq = kargs()->in[12] + (size_t)o * 4 * 128;
      float d1 = lq[lane] * lq[128 + lane] + lq[64 + lane] * lq[128 + 64 + lane], d2 = lq[256 + lane] * lq[384 + lane] + lq[256 + 64 + lane] * lq[384 + 64 + lane];
      d1 = wave_sum(d1); d2 = wave_sum(d2); lam = expf(d1) - expf(d2) + lambda_init; lam = __uint_as_float(__builtin_amdgcn_readfirstlane(__float_as_uint(lam))); }
    __syncthreads();
    LAS float* tab = (LAS float*)(LAS unsigned char*)(lds + att::OFF_TAB);
    if (tid < 385) tab[tid] = kargs()->in[15][t5_bucket(tid - 192) * 8 + h];
    __syncthreads();
    const size_t row0 = (size_t)b * SEQ + (size_t)qb * 256;
    const bf16_t* Qrow = QKV + row0 * QKV_N + h * 256;
    const bf16_t* Kb = QKV + (size_t)b * SEQ * QKV_N + 2048 + h * 256;
    const bf16_t* Vb = QKV + (size_t)b * SEQ * QKV_N + 4096 + h * 256;
    float* Ob = SCR + row0 * DM + h * 256;
#pragma unroll 1
    for (int c = 0; c < 2; ++c) {
        __syncthreads();
        att::attn_pass(Qrow + c * 128, Kb + c * 128, Vb, Ob, c, lam, qb * 256, SEQ, (char*)lds, wv);
    }
    {
        const int tid2 = otid(wv), lane2 = tid2 & 63, wid2 = __builtin_amdgcn_readfirstlane(tid2 >> 6);
        const int srow = lane2 >> 5, sc4 = (lane2 & 31) * 4;
        const float sc1 = 1.0f - (0.8f - 0.6f * expf(-0.3f * (float)layer));
        const float* gsub = kargs()->in[13] + (size_t)o * 256;
        const f32x4 g0 = *(const f32x4*)(gsub + sc4) * sc1, g1 = *(const f32x4*)(gsub + 128 + sc4) * sc1;
        const float* src = Ob + (size_t)(wid2 * 32 + srow) * DM + sc4;
        bf16_t* dst = OB + (row0 + wid2 * 32 + srow) * DM + h * 256 + sc4;
#pragma unroll 8
        for (int k = 0; k < 16; ++k) {
            const f32x4 a = *(const f32x4*)src, c = *(const f32x4*)(src + 128);
            float ss = ((a[0] * a[0] + a[1] * a[1]) + (a[2] * a[2] + a[3] * a[3])) + ((c[0] * c[0] + c[1] * c[1]) + (c[2] * c[2] + c[3] * c[3]));
            ss += DPP_F(ss, 0xB1); ss += DPP_F(ss, 0x4E); ss += DPP_F(ss, 0x141); ss += DPP_F(ss, 0x140); ss += SWZ_XOR(ss, 16);
            const float rr = 1.0f / sqrtf(ss * (1.0f / 256.0f) + EPS);
            const f32x4 y0 = a * rr * g0, y1 = c * rr * g1;
            u32x2 w0, w1; w0.x = cvt_pk_bf16(y0[0], y0[1]); w0.y = cvt_pk_bf16(y0[2], y0[3]); w1.x = cvt_pk_bf16(y1[0], y1[1]); w1.y = cvt_pk_bf16(y1[2], y1[3]);
            *(u32x2*)dst = w0; *(u32x2*)(dst + 128) = w1;
            src += 2 * DM; dst += 2 * DM;
        }
    }
}

constexpr int N_PHASES = 1 + 7 * DEPTH;
__global__ void __launch_bounds__(512, 2) mega(Args a_unused) {
    extern __shared__ __attribute__((aligned(16))) unsigned char lds[];
    const int wv = __builtin_amdgcn_readfirstlane(threadIdx.x >> 6);
    const int lo = kargs()->lo;
#pragma unroll 1
    for (int ph = lo; ph < kargs()->hi; ++ph) {
        KArgs ap = kargs();
        const int G = gridDim.x, bx = blockIdx.x;
        const int vcu = (G % 8 == 0) ? (bx % 8) * (G / 8) + bx / 8 : bx;
        unsigned char* ws = ap->ws;
        bf16_t* H = (bf16_t*)(ws + WS_H);
        unsigned char* BIG = ws + WS_BIG;
        float* MBUF = (float*)(ws + WS_MBUF);
        const int tid = otid(wv), wid = __builtin_amdgcn_readfirstlane(tid >> 6), lane = tid & 63;
        const int gw = vcu * 8 + wid, NGW = G * 8;
        if (ph == 0) {
#ifndef NO_PREP
            prep_phase(lds, vcu, G, wv);
#endif
        } else {
            const int l = (ph - 1) / 7, s = (ph - 1) % 7, e = l >> 1;
            const bool even = (l & 1) == 0;
            if (s == 0) {
                if (even) { pg8::Gemm g{H, (const bf16_t*)(ws + WS_WIN + e * SZ_WIN), M_TOK, IN_AB, DM}; pg8::StaticOrder S; S.init(M_TOK, IN_AB, G, bx);
                    pg8::EpiGemm1 E{(bf16_t*)(BIG + BIG_AG), (bf16_t*)(BIG + BIG_ZU), (bf16_t*)(BIG + BIG_GV)};
#ifndef NO_G1
                    pg8::gemm_phase<pg8::EpiGemm1, pg8::StaticOrder>((LAS unsigned char*)lds, g, S, E, wv);
#endif
                } else { pg8::Gemm g{H, (const bf16_t*)(ws + WS_WQKV + e * SZ_WQKV), M_TOK, QKV_N, DM}; pg8::StaticOrder S; S.init(M_TOK, QKV_N, G, bx);
                    pg8::EpiQKV E{(bf16_t*)(BIG + BIG_QKV), QKV_N, 8};
#ifndef NO_GQKV
                    pg8::gemm_phase<pg8::EpiQKV, pg8::StaticOrder>((LAS unsigned char*)lds, g, S, E, wv);
#endif
                }
            } else if (s == 1) {
                if (even) {
#ifndef NO_CONV
                    for (int it = vcu; it < 512; it += G)
                        conv_item(it, (const bf16_t*)(BIG + BIG_AG), ap->in[3] + (size_t)e * CONV_W * 1024, ap->in[4] + e * 1024, ap->in[5] + e * 1024, (bf16_t*)(BIG + BIG_CAT), lds, wv);
#endif
#ifndef NO_SGU
                    for (int it = vcu; it < 1024; it += G)
                        sgu_item(it, (const bf16_t*)(BIG + BIG_GV), (const bf16_t*)(BIG + BIG_ZU), ap->in[6] + e * 1024, ap->in[7] + e * 1024, ap->in[8] + (size_t)e * 8 * 128 * 128, ap->in[9] + e * 8 * 128, (bf16_t*)(BIG + BIG_CAT), lds, wv);
#endif
                } else {
#ifndef NO_ATT
                    for (int it = vcu; it < 512; it += G)
                        attn_item(it, l, (const bf16_t*)(BIG + BIG_QKV), MBUF, (bf16_t*)(BIG + BIG_OB), lds, wv);
#endif
                }
            } else if (s == 2 || s == 5) {
                const bf16_t* A; const bf16_t* Bt; int K;
                if (s == 2) { K = DM; if (even) { A = (const bf16_t*)(BIG + BIG_CAT); Bt = (const bf16_t*)(ws + WS_WOAB + e * SZ_WOAB); } else { A = (const bf16_t*)(BIG + BIG_OB); Bt = (const bf16_t*)(ws + WS_WOC + e * SZ_WOC); } }
                else { K = DFF; A = (const bf16_t*)(BIG + BIG_ACT); Bt = (const bf16_t*)(ws + WS_WDN + l * SZ_WDN); }
                pg8::Gemm g{A, Bt, M_TOK, DM, K}; pg8::StaticOrder S; S.init(M_TOK, DM, G, bx);
                pg8::EpiQKV E{(bf16_t*)MBUF, DM, 0};
#ifndef NO_GF32
                pg8::gemm_phase<pg8::EpiQKV, pg8::StaticOrder>((LAS unsigned char*)lds, g, S, E, wv);
#endif
            } else if (s == 3) {
                const float* xin = (l == 0) ? ap->in[0] : ap->out;
                norm_phase((const bf16_t*)MBUF, ap->in[1] + (size_t)(l * 4 + 1) * DM, xin, ap->out, ap->in[1] + (size_t)(l * 4 + 2) * DM, H, gw, NGW, lane);
            } else if (s == 4) {
                pg8::Gemm g{H, (const bf16_t*)(ws + WS_WGU + l * SZ_WGU), M_TOK, 2 * DFF, DM}; pg8::StaticOrder S; S.init(M_TOK, 2 * DFF, G, bx);
                pg8::EpiSwiGLU E{(bf16_t*)(BIG + BIG_ACT), DFF};
#ifndef NO_GSW
                pg8::gemm_phase<pg8::EpiSwiGLU, pg8::StaticOrder>((LAS unsigned char*)lds, g, S, E, wv);
#endif
            } else {
                const bool lastl = (l == DEPTH - 1);
                norm_phase((const bf16_t*)MBUF, ap->in[1] + (size_t)(l * 4 + 3) * DM, ap->out, ap->out, lastl ? nullptr : ap->in[1] + (size_t)((l + 1) * 4 + 0) * DM, lastl ? nullptr : H, gw, NGW, lane);
            }
        }
        if (ph + 1 < kargs()->hi) { if (kargs()->coop) cg::this_grid().sync(); }
    }
}

extern "C" void kernel_launch(void* const* d_in, const int* in_sizes, int n_in, void* d_out, int out_size, void* d_ws, size_t ws_size, hipStream_t stream) {
    static int grid = 0;
    if (grid == 0) {
        if (n_in != 19 || in_sizes[0] != M_TOK * DM || out_size != M_TOK * DM || ws_size < WS_END) {
            fprintf(stderr, "kernel_launch: shape mismatch n_in %d in0 %d out %d ws %zu (need %zu)\n", n_in, n_in > 0 ? in_sizes[0] : -1, out_size, ws_size, (size_t)WS_END); grid = -1; return; }
        int dev = 0, cus = 0, per_cu = 0;
        if (hipGetDevice(&dev) != hipSuccess || hipDeviceGetAttribute(&cus, hipDeviceAttributeMultiprocessorCount, dev) != hipSuccess) { grid = -1; return; }
        if (hipFuncSetAttribute((const void*)mega, hipFuncAttributeMaxDynamicSharedMemorySize, LDS_BYTES) != hipSuccess) { fprintf(stderr, "kernel_launch: hipFuncSetAttribute failed\n"); grid = -1; return; }
        if (hipOccupancyMaxActiveBlocksPerMultiprocessor(&per_cu, (const void*)mega, 512, LDS_BYTES) != hipSuccess || per_cu < 1) { fprintf(stderr, "kernel_launch: occupancy query says %d\n", per_cu); per_cu = 1; }
        (void)hipGetLastError();
        grid = cus * 1;
        (void)per_cu;
    }
    if (grid < 0) return;
    Args a{};
    for (int i = 0; i < 19; ++i) a.in[i] = (const float*)d_in[i];
    a.out = (float*)d_out; a.ws = (unsigned char*)d_ws;
#if N_LAUNCH_MODE == 1
    for (int ph = 0; ph < N_PHASES; ++ph) { a.lo = ph; a.hi = ph + 1; a.coop = 0; a.pad = 0;
        int ptype = 0;
        if (ph > 0) { const int l_ = (ph - 1) / 7, s_ = (ph - 1) % 7; ptype = (s_ == 0) ? 1 : (s_ == 1) ? (((l_ & 1) == 0) ? 2 : 3) : (s_ == 2 || s_ == 5) ? 4 : (s_ == 4) ? 5 : 6; }
        const int nrep = ((DUP_MASK >> ptype) & 1) ? 2 : 1;
        for (int rep = 0; rep < nrep; ++rep) hipLaunchKernelGGL(mega, dim3(grid), dim3(512), LDS_BYTES, stream, a); }
#else
    a.lo = 0; a.hi = N_PHASES; a.coop = 1; a.pad = 0;
    void* args[] = {&a};
    hipError_t e = hipLaunchCooperativeKernel((const void*)mega, dim3(grid), dim3(512), args, LDS_BYTES, stream);
    if (e != hipSuccess) fprintf(stderr, "kernel_launch: cooperative launch failed: %s (grid %d)\n", hipGetErrorString(e), grid);
#endif
}
```

```cpp
#include <hip/hip_runtime.h>
#include <hip/hip_cooperative_groups.h>
#include <cstdio>
#include <cstdint>
namespace cg = cooperative_groups;

#ifndef N_LAUNCH_MODE
#define N_LAUNCH_MODE 0
#endif

#ifndef DUP_MASK
#define DUP_MASK 0
#endif
#define LAS __attribute__((address_space(3)))
typedef unsigned short bf16_t;
typedef short bf16x8 __attribute__((ext_vector_type(8)));
typedef short s16x4 __attribute__((ext_vector_type(4)));
typedef float f32x2 __attribute__((ext_vector_type(2)));
typedef float f32x4 __attribute__((ext_vector_type(4)));
typedef float f32x16 __attribute__((ext_vector_type(16)));
typedef unsigned u32x2 __attribute__((ext_vector_type(2)));
typedef unsigned u32x4 __attribute__((ext_vector_type(4)));

constexpr int M_TOK = 16384, DM = 2048, SEQ = 4096, NBATCH = 4, DFF = 5632, DEPTH = 4;
constexpr int CONV_CH = 1024, CONV_W = 31, SGU_CH = 1024;
constexpr int IN_AB = 4096, QKV_N = 6144;
constexpr float EPS = 1e-6f;
constexpr float LOG2E = 1.4426950408889634f;

constexpr size_t SZ_WIN = (size_t)IN_AB * DM * 2, SZ_WOAB = (size_t)DM * DM * 2, SZ_WQKV = (size_t)QKV_N * DM * 2, SZ_WOC = (size_t)DM * DM * 2;
constexpr size_t SZ_WGU = (size_t)2 * DFF * DM * 2, SZ_WDN = (size_t)DM * DFF * 2;
constexpr size_t WS_WIN = 0, WS_WOAB = WS_WIN + 2 * SZ_WIN, WS_WQKV = WS_WOAB + 2 * SZ_WOAB, WS_WOC = WS_WQKV + 2 * SZ_WQKV;
constexpr size_t WS_WGU = WS_WOC + 2 * SZ_WOC, WS_WDN = WS_WGU + 4 * SZ_WGU, WS_H = WS_WDN + 4 * SZ_WDN;
constexpr size_t WS_BIG = WS_H + (size_t)M_TOK * DM * 2;
constexpr size_t SZ_BIG = (size_t)M_TOK * (QKV_N + DM) * 2;
constexpr size_t WS_MBUF = WS_BIG + SZ_BIG;
constexpr size_t WS_END = WS_MBUF + (size_t)M_TOK * DM * 4;
constexpr size_t BIG_AG = 0, BIG_ZU = (size_t)M_TOK * 1024 * 2, BIG_GV = 2 * BIG_ZU, BIG_CAT = 3 * BIG_ZU;
constexpr size_t BIG_QKV = 0, BIG_OB = (size_t)M_TOK * QKV_N * 2;
constexpr size_t BIG_ACT = 0;

constexpr int LDS_BYTES = 151552;

__device__ __forceinline__ unsigned cvt_pk_bf16(float lo, float hi) { unsigned r; asm volatile("v_cvt_pk_bf16_f32 %0, %1, %2" : "=v"(r) : "v"(lo), "v"(hi)); return r; }
__device__ __forceinline__ float bf_lo(unsigned v) { return __uint_as_float(v << 16); }
__device__ __forceinline__ float bf_hi(unsigned v) { return __uint_as_float(v & 0xffff0000u); }
__device__ __forceinline__ int otid(int wv) { int l; asm volatile("v_mbcnt_lo_u32_b32 %0, -1, 0\n\tv_mbcnt_hi_u32_b32 %0, -1, %0" : "=v"(l)); return wv * 64 + l; }
#define SWZ_XOR(v, k) __int_as_float(__builtin_amdgcn_ds_swizzle(__float_as_int(v), ((k) << 10) | 0x1f))
#define DPP_F(v, ctrl) __int_as_float(__builtin_amdgcn_update_dpp(0, __float_as_int(v), (ctrl), 0xf, 0xf, false))
__device__ __forceinline__ float wave_sum(float v) {
    v += DPP_F(v, 0xB1); v += DPP_F(v, 0x4E); v += DPP_F(v, 0x141); v += DPP_F(v, 0x140); v += SWZ_XOR(v, 16);
    auto rr = __builtin_amdgcn_permlane32_swap(__float_as_uint(v), __float_as_uint(v), false, false);
    return __uint_as_float(rr[0]) + __uint_as_float(rr[1]);
}
__device__ __forceinline__ float sigmoid_f(float x) { return __builtin_amdgcn_rcpf(1.0f + __builtin_amdgcn_exp2f(-x * LOG2E)); }
__device__ __forceinline__ f32x2 gelu_pk(f32x2 v) {
    const f32x2 av = __builtin_elementwise_abs(v), d = av * 0.2316418882f + 1.0f;
    f32x2 t; t.x = __builtin_amdgcn_rcpf(d.x); t.y = __builtin_amdgcn_rcpf(d.y);
    f32x2 q = t * 0.5307027145f + (-0.7265760135f); q = q * t + 0.7107068705f; q = q * t + (-0.142248368f); q = q * t + 0.127414796f; q = q * t;
    const f32x2 s = (v * v) * (-0.72134752044f);
    f32x2 e; e.x = __builtin_amdgcn_exp2f(s.x); e.y = __builtin_amdgcn_exp2f(s.y);
    const f32x2 m = v * (q * e), r = v - m;
    f32x2 o; o.x = v.x < 0.f ? m.x : r.x; o.y = v.y < 0.f ? m.y : r.y; return o;
}

namespace pg8 {
constexpr int BM = 256, BK = 64, HALF = 128, HTB = HALF * BK * 2, STAGE_BYTES = 8 * HTB, NXCD = 8, WGM = 4;
__host__ __device__ __forceinline__ int lds_byte(int r, int c) { const int st = (r >> 4) * 2 + (c >> 5), rr = r & 15, cc = c & 31, ob = rr * 64 + cc * 2; return st * 1024 + (ob ^ (((ob >> 9) & 1) << 5)); }
__host__ __device__ __forceinline__ void stage_rc(int b, int& R, int& C) { const int st = b / 1024, sb = b % 1024, swz = sb ^ (((sb >> 9) & 1) << 5); R = (st >> 1) * 16 + swz / 64; C = (st & 1) * 32 + (swz % 64) / 2; }
__host__ __device__ __forceinline__ int perm32(int rho) { const int n = rho >> 4, i = rho & 15; return 8 * (i >> 2) + 4 * n + (i & 3); }

struct Unit { int pm, pn; };
struct Gemm { const bf16_t* A; const bf16_t* Bt; int M, N, K; };
struct StaticOrder {
    int nM, nN, nwg, G, c;
    __device__ void init(int M, int N, int G_, int c_) { nM = M / BM; nN = N / BM; nwg = nM * nN; G = G_; c = c_; }
    __device__ bool next(int i, Unit& u) const {
        const long L = (long)i * G + c; if (L >= nwg) return false;
        int wgid = (int)L; { const int q = nwg / NXCD, r = nwg % NXCD, xcd = wgid % NXCD, off = wgid / NXCD; wgid = (xcd < r ? xcd * (q + 1) : r * (q + 1) + (xcd - r) * q) + off; }
        const int nig = WGM * nN, gid = wgid / nig, fm = gid * WGM, gsz = (nM - fm) < WGM ? (nM - fm) : WGM;
        u.pm = fm + ((wgid % nig) % gsz); u.pn = (wgid % nig) / gsz; return true;
    }
    __device__ __forceinline__ void a_ready(const Unit&) const {}
    __device__ __forceinline__ void done(const Unit&) const {}
};

struct EpiF32 {
    static constexpr bool PERM = false, AFTER_DRAIN = false;
    float* C; int ldc;
    __device__ __forceinline__ void operator()(const f32x4 (&acc)[2][2][4][2], const Unit& u, int wr, int wc, int fr, int fq) const {
        const int row0 = u.pm * BM + wr * 64 + fr, col0 = u.pn * BM + wc * 32 + 4 * fq;
#pragma unroll
        for (int ai = 0; ai < 2; ++ai)
#pragma unroll
            for (int m = 0; m < 4; ++m) { float* rowp = C + (size_t)(row0 + ai * HALF + m * 16) * ldc + col0;
#pragma unroll
                for (int bj = 0; bj < 2; ++bj)
#pragma unroll
                    for (int n = 0; n < 2; ++n) *(f32x4*)(rowp + bj * HALF + n * 16) = acc[ai][bj][m][n]; }
    }
};
struct EpiQKV {
    static constexpr bool PERM = true, AFTER_DRAIN = false;
    bf16_t* O; int ldc; int qtiles;
    __device__ __forceinline__ void operator()(const f32x4 (&acc)[2][2][4][2], const Unit& u, int wr, int wc, int fr, int fq) const {
        const int row0 = u.pm * BM + wr * 64 + fr, col0 = u.pn * BM + wc * 32 + 8 * fq;
        const float sc = (u.pn < qtiles) ? 0.08838834764831845f : 1.0f;
#pragma unroll
        for (int ai = 0; ai < 2; ++ai)
#pragma unroll
            for (int m = 0; m < 4; ++m) { bf16_t* rowp = O + (size_t)(row0 + ai * HALF + m * 16) * ldc + col0;
#pragma unroll
                for (int bj = 0; bj < 2; ++bj) { const f32x4 v0 = acc[ai][bj][m][0] * sc, v1 = acc[ai][bj][m][1] * sc;
                    u32x4 w; w.x = cvt_pk_bf16(v0[0], v0[1]); w.y = cvt_pk_bf16(v0[2], v0[3]); w.z = cvt_pk_bf16(v1[0], v1[1]); w.w = cvt_pk_bf16(v1[2], v1[3]);
                    *(u32x4*)(rowp + bj * HALF) = w; } }
    }
};
struct EpiSwiGLU {
    static constexpr bool PERM = true, AFTER_DRAIN = false;
    bf16_t* O; int ldc;
    __device__ __forceinline__ void operator()(const f32x4 (&acc)[2][2][4][2], const Unit& u, int wr, int wc, int fr, int fq) const {
        const int row0 = u.pm * BM + wr * 64 + fr, col0 = u.pn * HALF + wc * 32 + 8 * fq;
#pragma unroll
        for (int ai = 0; ai < 2; ++ai)
#pragma unroll
            for (int m = 0; m < 4; ++m) { bf16_t* rowp = O + (size_t)(row0 + ai * HALF + m * 16) * ldc + col0;
                float v[8];
#pragma unroll
                for (int n = 0; n < 2; ++n)
#pragma unroll
                    for (int j = 0; j < 4; ++j) { const float g = acc[ai][0][m][n][j], up = acc[ai][1][m][n][j]; v[n * 4 + j] = g * sigmoid_f(g) * up; }
                u32x4 w; w.x = cvt_pk_bf16(v[0], v[1]); w.y = cvt_pk_bf16(v[2], v[3]); w.z = cvt_pk_bf16(v[4], v[5]); w.w = cvt_pk_bf16(v[6], v[7]);
                *(u32x4*)rowp = w; }
    }
};
struct EpiGemm1 {
    static constexpr bool PERM = true, AFTER_DRAIN = false;
    bf16_t* AG; bf16_t* ZU; bf16_t* GV;
    __device__ __forceinline__ void operator()(const f32x4 (&acc)[2][2][4][2], const Unit& u, int wr, int wc, int fr, int fq) const {
        const int row0 = u.pm * BM + wr * 64 + fr;
        if (u.pn < 8) {
            const int col0 = u.pn * HALF + wc * 32 + 8 * fq;
#pragma unroll
            for (int ai = 0; ai < 2; ++ai)
#pragma unroll
                for (int m = 0; m < 4; ++m) { bf16_t* rowp = AG + (size_t)(row0 + ai * HALF + m * 16) * 1024 + col0;
                    float v[8];
#pragma unroll
                    for (int n = 0; n < 2; ++n)
#pragma unroll
                        for (int j = 0; j < 4; ++j) v[n * 4 + j] = acc[ai][0][m][n][j] * sigmoid_f(acc[ai][1][m][n][j]);
                    u32x4 w; w.x = cvt_pk_bf16(v[0], v[1]); w.y = cvt_pk_bf16(v[2], v[3]); w.z = cvt_pk_bf16(v[4], v[5]); w.w = cvt_pk_bf16(v[6], v[7]);
                    *(u32x4*)rowp = w; }
        } else {
            bf16_t* O = (u.pn < 12) ? ZU : GV; const int col0 = ((u.pn - 8) & 3) * BM + wc * 32 + 8 * fq;
#pragma unroll
            for (int ai = 0; ai < 2; ++ai)
#pragma unroll
                for (int m = 0; m < 4; ++m) { bf16_t* rowp = O + (size_t)(row0 + ai * HALF + m * 16) * 1024 + col0;
#pragma unroll
                    for (int bj = 0; bj < 2; ++bj) { const f32x4 v0 = acc[ai][bj][m][0], v1 = acc[ai][bj][m][1];
                        const f32x2 a = gelu_pk((f32x2){v0[0], v0[1]}), b = gelu_pk((f32x2){v0[2], v0[3]}), c = gelu_pk((f32x2){v1[0], v1[1]}), d = gelu_pk((f32x2){v1[2], v1[3]});
                        u32x4 w; w.x = cvt_pk_bf16(a.x, a.y); w.y = cvt_pk_bf16(b.x, b.y); w.z = cvt_pk_bf16(c.x, c.y); w.w = cvt_pk_bf16(d.x, d.y);
                        *(u32x4*)(rowp + bj * HALF) = w; } }
        }
    }
};

template <class Epi, class Sched>
__device__ __forceinline__ void gemm_phase(LAS unsigned char* lds, const Gemm g, const Sched& S, const Epi& E, const int wv) {
    const int tid = otid(wv), wid = __builtin_amdgcn_readfirstlane(tid >> 6), lane = tid & 63, wr = wid >> 2, wc = wid & 3, fr = lane & 15, fq = lane >> 4;
    const int K = g.K, nt = K / BK;
    unsigned voffA[2], voffB[2];
#pragma unroll
    for (int i = 0; i < 2; ++i) { int R, C; stage_rc(tid * 16 + i * 8192, R, C); const int Rb = Epi::PERM ? ((R & ~31) + perm32(R & 31)) : R;
        voffA[i] = (unsigned)(R * K + C) * 2u; voffB[i] = (unsigned)(Rb * K + C) * 2u; }
    const size_t kstep = (size_t)(BK * 2);
    const size_t hstep = (size_t)HALF * K * 2;
    const size_t tstep = 2 * hstep;
    const unsigned ldsw = (unsigned)wid * 1024u;
    const int aoff = lds_byte(wr * 64 + fr, fq * 8), boff = lds_byte(wc * 32 + fr, fq * 8);
#define PG8_SA(b, h) (((b) * 2 + (h)) * HTB)
#define PG8_SB(b, h) ((4 + (b) * 2 + (h)) * HTB)
#define PG8_STAGE(bufoff, gbase, voff) do { _Pragma("unroll") for (int _i = 0; _i < 2; ++_i) \
        __builtin_amdgcn_global_load_lds((const unsigned*)((const char*)(gbase) + (voff)[_i]), (LAS unsigned*)(lds + (bufoff) + ldsw + _i * 8192), 16, 0, 0); } while (0)
#define PG8_LDA(dst, b, h) do { _Pragma("unroll") for (int m = 0; m < 4; ++m) _Pragma("unroll") for (int k = 0; k < 2; ++k) dst[m][k] = *(const LAS bf16x8*)(lds + PG8_SA(b, h) + aoff + m * 2048 + k * 1024); } while (0)
#define PG8_LDB(dst, b, h) do { _Pragma("unroll") for (int n = 0; n < 2; ++n) _Pragma("unroll") for (int k = 0; k < 2; ++k) dst[n][k] = *(const LAS bf16x8*)(lds + PG8_SB(b, h) + boff + n * 2048 + k * 1024); } while (0)
#define PG8_MMA(ai, bj, At, Bt) do { __builtin_amdgcn_s_setprio(1); _Pragma("unroll") for (int m = 0; m < 4; ++m) _Pragma("unroll") for (int n = 0; n < 2; ++n) _Pragma("unroll") for (int k = 0; k < 2; ++k) \
        acc[ai][bj][m][n] = __builtin_amdgcn_mfma_f32_16x16x32_bf16(Bt[n][k], At[m][k], acc[ai][bj][m][n], 0, 0, 0); __builtin_amdgcn_s_setprio(0); } while (0)
#define PG8_WAIT_V(n) asm volatile("s_waitcnt vmcnt(" #n ")" ::: "memory")
#define PG8_WAIT_L(n) asm volatile("s_waitcnt lgkmcnt(" #n ")" ::: "memory")
#define PG8_BAR __builtin_amdgcn_s_barrier()
#define PG8_SCHED __builtin_amdgcn_sched_barrier(0)
    Unit cur, nxt; int ui = 0;
    if (!S.next(0, cur)) return;
    f32x4 acc[2][2][4][2];
#pragma unroll
    for (int a = 0; a < 2; ++a)
#pragma unroll
        for (int b = 0; b < 2; ++b)
#pragma unroll
            for (int m = 0; m < 4; ++m)
#pragma unroll
                for (int n = 0; n < 2; ++n) acc[a][b][m][n] = (f32x4){0.f, 0.f, 0.f, 0.f};
    bf16x8 At[4][2], B0[2][2], B1[2][2];
    const char* cA = (const char*)g.A + (size_t)cur.pm * tstep; const char* cB = (const char*)g.Bt + (size_t)cur.pn * tstep;
    S.a_ready(cur);
    PG8_STAGE(PG8_SB(0, 0), cB, voffB); PG8_STAGE(PG8_SB(0, 1), cB + hstep, voffB); PG8_STAGE(PG8_SA(0, 0), cA, voffA); PG8_STAGE(PG8_SA(0, 1), cA + hstep, voffA);
    if (wr == 1) PG8_BAR;
    PG8_WAIT_V(2); PG8_BAR;
    PG8_STAGE(PG8_SB(1, 0), cB + kstep, voffB); PG8_STAGE(PG8_SA(1, 0), cA + kstep, voffA); PG8_STAGE(PG8_SB(1, 1), cB + hstep + kstep, voffB);
    PG8_WAIT_V(6); PG8_BAR;
    for (;;) {
        const bool has_next = S.next(ui + 1, nxt);
        const char* nA = has_next ? (const char*)g.A + (size_t)nxt.pm * tstep : cA; const char* nB = has_next ? (const char*)g.Bt + (size_t)nxt.pn * tstep : cB;
        for (int t = 0; t < nt; t += 2) {
            const bool last = (t == nt - 2);
            const char* a1 = cA + (size_t)(t + 1) * kstep;
            const char* a2 = last ? nA : cA + (size_t)(t + 2) * kstep; const char* b2 = last ? nB : cB + (size_t)(t + 2) * kstep;
            const char* a3 = a2 + kstep; const char* b3 = b2 + kstep;
            if (last && has_next) S.a_ready(nxt);
            PG8_LDB(B0, 0, 0); PG8_LDB(B1, 0, 1); PG8_SCHED; PG8_LDA(At, 0, 0); PG8_STAGE(PG8_SA(1, 1), a1 + hstep, voffA);
            PG8_WAIT_V(8); PG8_WAIT_L(0); PG8_BAR; PG8_MMA(0, 0, At, B0); PG8_MMA(0, 1, At, B1); PG8_BAR; PG8_SCHED;
            PG8_LDA(At, 0, 1); PG8_STAGE(PG8_SB(0, 0), b2, voffB); PG8_STAGE(PG8_SB(0, 1), b2 + hstep, voffB); PG8_STAGE(PG8_SA(0, 0), a2, voffA);
            PG8_WAIT_V(8); PG8_WAIT_L(0); PG8_BAR; PG8_MMA(1, 0, At, B0); PG8_MMA(1, 1, At, B1); PG8_BAR; PG8_SCHED;
            PG8_LDB(B0, 1, 0); PG8_LDB(B1, 1, 1); PG8_SCHED; PG8_LDA(At, 1, 0); PG8_STAGE(PG8_SA(0, 1), a2 + hstep, voffA);
            PG8_WAIT_V(8); PG8_WAIT_L(0); PG8_BAR; PG8_MMA(0, 0, At, B0); PG8_MMA(0, 1, At, B1); PG8_BAR; PG8_SCHED;
            PG8_LDA(At, 1, 1); PG8_STAGE(PG8_SB(1, 0), b3, voffB); PG8_STAGE(PG8_SB(1, 1), b3 + hstep, voffB); PG8_STAGE(PG8_SA(1, 0), a3, voffA);
            PG8_WAIT_V(8); PG8_WAIT_L(0); PG8_BAR; PG8_MMA(1, 0, At, B0); PG8_MMA(1, 1, At, B1); PG8_BAR; PG8_SCHED;
        }
        if (wr == 0) PG8_BAR;
        E(acc, cur, wr, wc, fr, fq); S.done(cur);
        if (!has_next) break;
#pragma unroll
        for (int a = 0; a < 2; ++a)
#pragma unroll
            for (int b = 0; b < 2; ++b)
#pragma unroll
                for (int m = 0; m < 4; ++m)
#pragma unroll
                    for (int n = 0; n < 2; ++n) acc[a][b][m][n] = (f32x4){0.f, 0.f, 0.f, 0.f};
        cur = nxt; cA = nA; cB = nB; ++ui;
        if (wr == 1) PG8_BAR;
    }
    PG8_WAIT_V(0);
    PG8_BAR;
#undef PG8_SA
#undef PG8_SB
#undef PG8_STAGE
#undef PG8_LDA
#undef PG8_LDB
#undef PG8_MMA
#undef PG8_WAIT_V
#undef PG8_WAIT_L
#undef PG8_BAR
#undef PG8_SCHED
}
}

namespace att {
constexpr int D = 128, NW = 8, QBLK = 32, KVBLK = 64;
constexpr float THR = 8.f;
constexpr int LDQ = QKV_N, LDK = QKV_N, LDO = DM;
constexpr int NBUF = 3, BUF_V = KVBLK * D * 2, BUF_BYTES = 3 * BUF_V;
constexpr int OFF_WS = NBUF * BUF_BYTES, OFF_TAB = OFF_WS + NW * 64 * 4, ATT_LDS = OFF_TAB + 2048;
#define KSWZ(row, colB) ((row) * 256 + ((colB) ^ (((row) & 15) << 4)))
#define SBAR() __builtin_amdgcn_sched_barrier(0)
__device__ __forceinline__ int crow(int r, int hi) { return (r & 3) + 8 * (r >> 2) + 4 * hi; }

__device__ __forceinline__ void partialSM(f32x16& p0, f32x16& p1, float& m_reg, float& mn, float& alpha) {
  constexpr float C = LOG2E;
  float pmax = p0[0];
#pragma unroll
  for (int r = 1; r < 16; ++r) pmax = fmaxf(pmax, p0[r]);
#pragma unroll
  for (int r = 0; r < 16; ++r) pmax = fmaxf(pmax, p1[r]);
  { auto rr = __builtin_amdgcn_permlane32_swap(__float_as_uint(pmax), __float_as_uint(pmax), false, false);
    pmax = fmaxf(__uint_as_float(rr[0]), __uint_as_float(rr[1])); }
  if (__builtin_expect(__all(pmax - m_reg <= THR), 1)) { mn = m_reg; alpha = 1.f; }
  else { mn = fmaxf(m_reg, pmax); alpha = __builtin_amdgcn_exp2f((m_reg - mn) * C); m_reg = mn; }
  float mnC = -mn * C;
#pragma unroll
  for (int r = 0; r < 16; ++r) p0[r] = fmaf(p0[r], C, mnC);
#pragma unroll
  for (int r = 0; r < 16; ++r) p1[r] = fmaf(p1[r], C, mnC);
#pragma unroll
  for (int r = 0; r < 16; ++r) p0[r] = __builtin_amdgcn_exp2f(p0[r]);
}
__device__ __forceinline__ void finishSM(f32x16& p0, f32x16& p1, float alpha, float& l_reg, bf16x8& pa0, bf16x8& pa1, bf16x8& pa2, bf16x8& pa3) {
#pragma unroll
  for (int r = 0; r < 16; ++r) p1[r] = __builtin_amdgcn_exp2f(p1[r]);
  float ps = 0;
#pragma unroll
  for (int r = 0; r < 16; ++r) ps += p0[r];
#pragma unroll
  for (int r = 0; r < 16; ++r) ps += p1[r];
  { auto rr = __builtin_amdgcn_permlane32_swap(__float_as_uint(ps), __float_as_uint(ps), false, false);
    ps = __uint_as_float(rr[0]) + __uint_as_float(rr[1]); }
  l_reg = l_reg * alpha + ps;
#define PK4(P, BASE, OUT) do { unsigned a0 = cvt_pk_bf16(P[BASE + 0], P[BASE + 1]), a1 = cvt_pk_bf16(P[BASE + 2], P[BASE + 3]);   \
    unsigned b0 = cvt_pk_bf16(P[BASE + 4], P[BASE + 5]), b1 = cvt_pk_bf16(P[BASE + 6], P[BASE + 7]);                              \
    auto r0 = __builtin_amdgcn_permlane32_swap(a0, b0, false, false); auto r1 = __builtin_amdgcn_permlane32_swap(a1, b1, false, false); \
    u32x4 w = {r0[0], r1[0], r0[1], r1[1]}; OUT = *reinterpret_cast<bf16x8*>(&w); } while (0)
  PK4(p0, 0, pa0); PK4(p0, 8, pa1); PK4(p1, 0, pa2); PK4(p1, 8, pa3);
#undef PK4
}
__device__ __forceinline__ void qkt(f32x16& p0, f32x16& p1, const char* Ks, const bf16x8* qr, int r32, int hi, const LAS float* tab, int rel0, int farmode) {
  if (farmode != 0) { const float c = tab[farmode < 0 ? 0 : 384];
#pragma unroll
    for (int r = 0; r < 16; ++r) { p0[r] = c; p1[r] = c; }
  } else {
    const LAS float* tb = tab + (rel0 + 192 + 4 * hi);
#pragma unroll
    for (int r = 0; r < 16; ++r) { p0[r] = tb[(r & 3) + 8 * (r >> 2)]; p1[r] = tb[32 + (r & 3) + 8 * (r >> 2)]; }
  }
#pragma unroll
  for (int d0 = 0; d0 < 8; ++d0) { int cb = (d0 * 16 + hi * 8) * 2;
    bf16x8 b0 = *reinterpret_cast<const bf16x8*>(Ks + KSWZ(r32, cb));
    bf16x8 b1 = *reinterpret_cast<const bf16x8*>(Ks + KSWZ(32 + r32, cb));
    p0 = __builtin_amdgcn_mfma_f32_32x32x16_bf16(b0, qr[d0], p0, 0, 0, 0);
    p1 = __builtin_amdgcn_mfma_f32_32x32x16_bf16(b1, qr[d0], p1, 0, 0, 0); }
}
__device__ __forceinline__ int v_st(int k, int c) { const int kk = (k & ~0xC) | ((k & 4) << 1) | ((k & 8) >> 1); return ((kk >> 3) * 4 + (c >> 5)) * 512 + ((kk & 7) * 32 + (c & 31)) * 2; }
__device__ __forceinline__ int v_rd_base(int lane) { return ((lane & 3) << 3) | (((lane >> 2) & 3) << 6) | (((lane >> 4) & 1) << 5) | (((lane >> 5) & 1) << 8); }
constexpr int v_rd_off(int d0, int ks, int half) { return d0 * 512 + ks * 4096 + half * 2048; }
template <int OFF> __device__ __forceinline__ s16x4 tr_read(int vb) {
  s16x4 r; asm volatile("ds_read_b64_tr_b16 %0, %1 offset:%2" : "=&v"(r) : "v"(vb), "i"(OFF) : "memory"); return r;
}
template <int D0> __device__ __forceinline__ void pv_one(f32x16& od, int vb, bf16x8 pa0, bf16x8 pa1, bf16x8 pa2, bf16x8 pa3) {
  const s16x4 l0 = tr_read<v_rd_off(D0, 0, 0)>(vb), h0 = tr_read<v_rd_off(D0, 0, 1)>(vb), l1 = tr_read<v_rd_off(D0, 1, 0)>(vb), h1 = tr_read<v_rd_off(D0, 1, 1)>(vb);
  const s16x4 l2 = tr_read<v_rd_off(D0, 2, 0)>(vb), h2 = tr_read<v_rd_off(D0, 2, 1)>(vb), l3 = tr_read<v_rd_off(D0, 3, 0)>(vb), h3 = tr_read<v_rd_off(D0, 3, 1)>(vb);
  asm volatile("s_waitcnt lgkmcnt(0)" ::: "memory"); SBAR();
#define PK(L, H) (bf16x8){L[0], L[1], L[2], L[3], H[0], H[1], H[2], H[3]}
  od = __builtin_amdgcn_mfma_f32_32x32x16_bf16(pa0, PK(l0, h0), od, 0, 0, 0);
  od = __builtin_amdgcn_mfma_f32_32x32x16_bf16(pa1, PK(l1, h1), od, 0, 0, 0);
  od = __builtin_amdgcn_mfma_f32_32x32x16_bf16(pa2, PK(l2, h2), od, 0, 0, 0);
  od = __builtin_amdgcn_mfma_f32_32x32x16_bf16(pa3, PK(l3, h3), od, 0, 0, 0);
#undef PK
}
__device__ __forceinline__ void pv_d0(f32x16* o, int vb, bf16x8 pa0, bf16x8 pa1, bf16x8 pa2, bf16x8 pa3) {
  pv_one<0>(o[0], vb, pa0, pa1, pa2, pa3); pv_one<1>(o[1], vb, pa0, pa1, pa2, pa3); pv_one<2>(o[2], vb, pa0, pa1, pa2, pa3); pv_one<3>(o[3], vb, pa0, pa1, pa2, pa3);
}
constexpr int v_off8(int d, int ks, int half) { return (d >> 2) * BUF_V + (d & 3) * 512 + ks * 4096 + half * 2048; }
#define PV_LOAD(S, DD) do { S[0] = tr_read<v_off8(DD, 0, 0)>(vb); S[1] = tr_read<v_off8(DD, 0, 1)>(vb); S[2] = tr_read<v_off8(DD, 1, 0)>(vb); S[3] = tr_read<v_off8(DD, 1, 1)>(vb); \
    S[4] = tr_read<v_off8(DD, 2, 0)>(vb); S[5] = tr_read<v_off8(DD, 2, 1)>(vb); S[6] = tr_read<v_off8(DD, 3, 0)>(vb); S[7] = tr_read<v_off8(DD, 3, 1)>(vb); } while (0)
#define PV_PK(L, H) (bf16x8){L[0], L[1], L[2], L[3], H[0], H[1], H[2], H[3]}
#define PV_MMA(OD, S) do { OD = __builtin_amdgcn_mfma_f32_32x32x16_bf16(pa0, PV_PK(S[0], S[1]), OD, 0, 0, 0); OD = __builtin_amdgcn_mfma_f32_32x32x16_bf16(pa1, PV_PK(S[2], S[3]), OD, 0, 0, 0); \
    OD = __builtin_amdgcn_mfma_f32_32x32x16_bf16(pa2, PV_PK(S[4], S[5]), OD, 0, 0, 0); OD = __builtin_amdgcn_mfma_f32_32x32x16_bf16(pa3, PV_PK(S[6], S[7]), OD, 0, 0, 0); } while (0)
#define PV_W8() do { asm volatile("s_waitcnt lgkmcnt(8)" ::: "memory"); SBAR(); } while (0)
#define PV_W0() do { asm volatile("s_waitcnt lgkmcnt(0)" ::: "memory"); SBAR(); } while (0)
__device__ __forceinline__ void pv8(f32x16* o, int vb, bf16x8 pa0, bf16x8 pa1, bf16x8 pa2, bf16x8 pa3) {
  s16x4 A[8], B[8];
  PV_LOAD(A, 0);
  PV_LOAD(B, 1); PV_W8(); PV_MMA(o[0], A); SBAR();
  PV_LOAD(A, 2); PV_W8(); PV_MMA(o[1], B); SBAR();
  PV_LOAD(B, 3); PV_W8(); PV_MMA(o[2], A); SBAR();
  PV_LOAD(A, 4); PV_W8(); PV_MMA(o[3], B); SBAR();
  PV_LOAD(B, 5); PV_W8(); PV_MMA(o[4], A); SBAR();
  PV_LOAD(A, 6); PV_W8(); PV_MMA(o[5], B); SBAR();
  PV_LOAD(B, 7); PV_W8(); PV_MMA(o[6], A); SBAR();
  PV_W0(); PV_MMA(o[7], B);
}

__device__ __forceinline__ void attn_pass(const bf16_t* __restrict__ Qb, const bf16_t* __restrict__ Kh, const bf16_t* __restrict__ Vh,
                                          float* Ob, int mode, float lam, int qpos0, int seq, char* lds, const int wv) {
  const int tid = otid(wv), wid = __builtin_amdgcn_readfirstlane(tid >> 6), lane = tid & 63, r32 = lane & 31, hi = lane >> 5;
  float* ws = (float*)(lds + OFF_WS) + wid * 64; float* li_l = ws; float* al_l = ws + 32;
  const LAS float* tab = (const LAS float*)(LAS char*)(lds + OFF_TAB);
  float m_reg = -1e30f, l_reg = 0; f32x16 o[8] = {}; bf16x8 qr[8];
  const bf16_t* Qw = Qb + (long)(wid * QBLK + r32) * LDQ + hi * 8;
#pragma unroll
  for (int d0 = 0; d0 < 8; ++d0) qr[d0] = *reinterpret_cast<const bf16x8*>(Qw + d0 * 16);
  const int vb0 = (int)(uintptr_t)(LAS char*)lds + BUF_V + v_rd_base(lane);
  const int qw0 = qpos0 + wid * QBLK, qlane = qw0 + r32;
  unsigned koff[2], voff[2];
#pragma unroll
  for (int i = 0; i < 2; ++i) { const int p = i * 512 + wid * 64 + lane;
    { const int row = p >> 4, g = p & 15; koff[i] = (unsigned)(row * LDK * 2 + ((g ^ (row & 15)) << 4)); }
    { const int kk = ((p >> 7) << 3) | ((p >> 2) & 7), c = ((p >> 5) & 3) * 32 + (p & 3) * 8; const int k = (kk & ~0xC) | ((kk & 4) << 1) | ((kk & 8) >> 1); voff[i] = (unsigned)(k * LDK * 2 + c * 2); } }
  LAS unsigned char* ldsw = (LAS unsigned char*)lds + wid * 1024;
#define DMA(tile, boff) do { const char* kg_ = (const char*)Kh + (size_t)(tile) * (KVBLK * LDK * 2); const char* vg_ = (const char*)Vh + (size_t)(tile) * (KVBLK * LDK * 2); \
    __builtin_amdgcn_global_load_lds((const unsigned*)(kg_ + koff[0]), (LAS unsigned*)(ldsw + (boff)), 16, 0, 0);                  \
    __builtin_amdgcn_global_load_lds((const unsigned*)(kg_ + koff[1]), (LAS unsigned*)(ldsw + (boff) + 8192), 16, 0, 0);           \
    __builtin_amdgcn_global_load_lds((const unsigned*)(vg_ + voff[0]), (LAS unsigned*)(ldsw + (boff) + BUF_V), 16, 0, 0);          \
    __builtin_amdgcn_global_load_lds((const unsigned*)(vg_ + voff[1]), (LAS unsigned*)(ldsw + (boff) + BUF_V + 8192), 16, 0, 0);   \
    __builtin_amdgcn_global_load_lds((const unsigned*)(vg_ + 256 + voff[0]), (LAS unsigned*)(ldsw + (boff) + 2 * BUF_V), 16, 0, 0);        \
    __builtin_amdgcn_global_load_lds((const unsigned*)(vg_ + 256 + voff[1]), (LAS unsigned*)(ldsw + (boff) + 2 * BUF_V + 8192), 16, 0, 0); } while (0)
#define STEP_SYNC() do { asm volatile("s_waitcnt vmcnt(0) lgkmcnt(0)" ::: "memory"); __builtin_amdgcn_s_barrier(); asm volatile("" ::: "memory"); } while (0)
#define RESC(a) do { if (__any((a) < 1.f)) { if (hi == 0) al_l[r32] = (a); asm volatile("s_waitcnt lgkmcnt(0)" ::: "memory"); \
    _Pragma("unroll") for (int d = 0; d < 8; ++d) _Pragma("unroll") for (int r = 0; r < 16; ++r) o[d][r] *= al_l[crow(r, hi)]; } } while (0)
#define FARMODE(k0) (((k0) + 63 - qw0 <= -91) ? -1 : (((k0) - (qw0 + 31) >= 91) ? 1 : 0))
  f32x16 p0, p1; float mn, al; bf16x8 pa0, pa1, pa2, pa3; const int NT = seq / KVBLK;
  int bprev = 0, bcur = 0, bnext = BUF_BYTES;
#define ROT() do { bprev = bcur; bcur = bnext; bnext = (bnext + BUF_BYTES == NBUF * BUF_BYTES) ? 0 : bnext + BUF_BYTES; } while (0)
  DMA(0, 0); STEP_SYNC();
  if (wid < 4) {
#pragma unroll 1
    for (int j = 0; j < NT; ++j) {
      if (j + 1 < NT) DMA(j + 1, bnext);
      SBAR();
      __builtin_amdgcn_s_setprio(1);
      { const int k0 = j * KVBLK; qkt(p0, p1, lds + bcur, qr, r32, hi, tab, k0 - qlane, FARMODE(k0)); }
      __builtin_amdgcn_s_setprio(0);
      partialSM(p0, p1, m_reg, mn, al);
      RESC(al);
      finishSM(p0, p1, al, l_reg, pa0, pa1, pa2, pa3); SBAR();
      __builtin_amdgcn_s_setprio(1);
      pv8(o, vb0 + bcur, pa0, pa1, pa2, pa3);
      __builtin_amdgcn_s_setprio(0);
      STEP_SYNC();
      ROT();
    }
  } else {
    DMA(1, bnext);
    SBAR();
    qkt(p0, p1, lds + bcur, qr, r32, hi, tab, 0 - qlane, FARMODE(0));
    partialSM(p0, p1, m_reg, mn, al);
    finishSM(p0, p1, al, l_reg, pa0, pa1, pa2, pa3); SBAR();
    STEP_SYNC();
    ROT();
#pragma unroll 1
    for (int j = 1; j < NT; ++j) {
      if (j + 1 < NT) DMA(j + 1, bnext);
      SBAR();
      __builtin_amdgcn_s_setprio(1);
      pv8(o, vb0 + bprev, pa0, pa1, pa2, pa3);
      SBAR();
      { const int k0 = j * KVBLK; qkt(p0, p1, lds + bcur, qr, r32, hi, tab, k0 - qlane, FARMODE(k0)); }
      __builtin_amdgcn_s_setprio(0);
      partialSM(p0, p1, m_reg, mn, al);
      RESC(al);
      finishSM(p0, p1, al, l_reg, pa0, pa1, pa2, pa3); SBAR();
      STEP_SYNC();
      ROT();
    }
    pv8(o, vb0 + bprev, pa0, pa1, pa2, pa3);
  }
#undef ROT
  if (hi == 0) li_l[r32] = l_reg; asm volatile("s_waitcnt lgkmcnt(0)" ::: "memory");
  float rli[16];
#pragma unroll
  for (int r = 0; r < 16; ++r) rli[r] = __builtin_amdgcn_rcpf(li_l[crow(r, hi)]);
  __syncthreads();
  float* stg = (float*)(lds + wid * 16384);
  float* Ow = Ob + (long)(wid * QBLK) * LDO;
  const int srow = lane >> 5, sc4 = (lane & 31) * 4;
#pragma unroll
  for (int half = 0; half < 2; ++half) {
#pragma unroll
    for (int d = 0; d < 4; ++d)
#pragma unroll
      for (int r = 0; r < 16; ++r) stg[crow(r, hi) * 128 + d * 32 + r32] = o[half * 4 + d][r] * rli[r];
    asm volatile("s_waitcnt lgkmcnt(0)" ::: "memory");
    if (mode == 0) {
#pragma unroll
      for (int k = 0; k < 16; ++k) { const int row = 2 * k + srow; const f32x4 v = *(const f32x4*)(stg + row * 128 + sc4);
        *(f32x4*)(Ow + (long)row * LDO + half * 128 + sc4) = v; }
    } else {
#pragma unroll
      for (int k = 0; k < 16; ++k) { const int row = 2 * k + srow; const f32x4 v = *(const f32x4*)(stg + row * 128 + sc4);
        f32x4* gp = (f32x4*)(Ow + (long)row * LDO + half * 128 + sc4); *gp = *gp - lam * v; }
    }
    asm volatile("s_waitcnt lgkmcnt(0)" ::: "memory");
  }
#undef DMA
#undef STEP_SYNC
#undef RESC
#undef FARMODE
}
}

struct Args { const float* in[19]; float* out; unsigned char* ws; int lo, hi, coop, pad; };
typedef const __attribute__((address_space(4))) Args* KArgs;
__device__ __forceinline__ KArgs kargs() { auto p = __builtin_amdgcn_kernarg_segment_ptr(); asm volatile("" : "+s"(p)); return (KArgs)p; }

struct TItem { const float* W; bf16_t* WT; int K, N, k0, n0, drow0; };
__device__ __forceinline__ void tile_load(const TItem& t, f32x4 (&v)[8], int lane) {
#pragma unroll
    for (int i = 0; i < 8; ++i) { const int kk = 8 * i + (lane >> 3); v[i] = *(const f32x4*)(t.W + (size_t)(t.k0 + kk) * t.N + t.n0 + 4 * (lane & 7)); }
}
__device__ __forceinline__ void tile_store(const TItem& t, const f32x4 (&v)[8], LAS float* scr, int lane) {
#pragma unroll
    for (int i = 0; i < 8; ++i) { const int kk = 8 * i + (lane >> 3); LAS float* s = scr + kk * 33 + 4 * (lane & 7); s[0] = v[i][0]; s[1] = v[i][1]; s[2] = v[i][2]; s[3] = v[i][3]; }
    asm volatile("s_waitcnt lgkmcnt(0)" ::: "memory");
    const int c = lane & 7;
#pragma unroll
    for (int j = 0; j < 4; ++j) { const int n = (lane >> 3) + 8 * j; const LAS float* s = scr + (8 * c) * 33 + n;
        u32x4 o; o.x = cvt_pk_bf16(s[0 * 33], s[1 * 33]); o.y = cvt_pk_bf16(s[2 * 33], s[3 * 33]); o.z = cvt_pk_bf16(s[4 * 33], s[5 * 33]); o.w = cvt_pk_bf16(s[6 * 33], s[7 * 33]);
        *(u32x4*)(t.WT + (size_t)(t.drow0 + n) * t.K + t.k0 + 8 * c) = o; }
    asm volatile("s_waitcnt lgkmcnt(0)" ::: "memory");
}

template <int NR> __device__ __forceinline__ void norm_phase_t(const bf16_t* mbuf, const float* ga, const float* xin, float* xout, const float* gb, bf16_t* hout, int gw, int NGW, int lane) {
    for (int row = gw; row < M_TOK; row += NR * NGW) {
        f32x4 xv[NR][8]; u32x4 mv[NR][4];
#pragma unroll
        for (int rr = 0; rr < NR; ++rr) { const int r = row + rr * NGW; if (r < M_TOK) {
            const float* xr = xin + (size_t)r * DM + 8 * lane;
#pragma unroll
            for (int j = 0; j < 4; ++j) { xv[rr][2 * j] = __builtin_nontemporal_load((const f32x4*)(xr + 512 * j)); xv[rr][2 * j + 1] = __builtin_nontemporal_load((const f32x4*)(xr + 512 * j + 4)); }
            if (mbuf) {
#pragma unroll
                for (int j = 0; j < 4; ++j) mv[rr][j] = __builtin_nontemporal_load((const u32x4*)(mbuf + (size_t)r * DM + 8 * lane + 512 * j)); } } }
#pragma unroll
        for (int rr = 0; rr < NR; ++rr) { const int r = row + rr * NGW; if (r < M_TOK) {
            if (mbuf) {
                float ss = 0.f;
#pragma unroll
                for (int j = 0; j < 4; ++j)
#pragma unroll
                    for (int k = 0; k < 4; ++k) { const float lo = bf_lo(mv[rr][j][k]), hi = bf_hi(mv[rr][j][k]); ss += lo * lo + hi * hi; }
                const float rs = 1.0f / sqrtf(wave_sum(ss) * (1.0f / DM) + EPS);
                float* xo = xout + (size_t)r * DM + 8 * lane;
#pragma unroll
                for (int j = 0; j < 4; ++j) { const f32x4 g0 = *(const f32x4*)(ga + 8 * lane + 512 * j), g1 = *(const f32x4*)(ga + 8 * lane + 512 * j + 4);
                    const f32x4 m0 = {bf_lo(mv[rr][j][0]), bf_hi(mv[rr][j][0]), bf_lo(mv[rr][j][1]), bf_hi(mv[rr][j][1])}, m1 = {bf_lo(mv[rr][j][2]), bf_hi(mv[rr][j][2]), bf_lo(mv[rr][j][3]), bf_hi(mv[rr][j][3])};
                    xv[rr][2 * j] = xv[rr][2 * j] + m0 * rs * g0; xv[rr][2 * j + 1] = xv[rr][2 * j + 1] + m1 * rs * g1;
                    __builtin_nontemporal_store(xv[rr][2 * j], (f32x4*)(xo + 512 * j)); __builtin_nontemporal_store(xv[rr][2 * j + 1], (f32x4*)(xo + 512 * j + 4)); }
            }
            if (hout) {
                float ss = 0.f;
#pragma unroll
                for (int j = 0; j < 8; ++j) ss += (xv[rr][j][0] * xv[rr][j][0] + xv[rr][j][1] * xv[rr][j][1]) + (xv[rr][j][2] * xv[rr][j][2] + xv[rr][j][3] * xv[rr][j][3]);
                const float rs = 1.0f / sqrtf(wave_sum(ss) * (1.0f / DM) + EPS);
                bf16_t* ho = hout + (size_t)r * DM + 8 * lane;
#pragma unroll
                for (int j = 0; j < 4; ++j) { const f32x4 g0 = *(const f32x4*)(gb + 8 * lane + 512 * j), g1 = *(const f32x4*)(gb + 8 * lane + 512 * j + 4);
                    const f32x4 y0 = xv[rr][2 * j] * rs * g0, y1 = xv[rr][2 * j + 1] * rs * g1;
                    u32x4 w; w.x = cvt_pk_bf16(y0[0], y0[1]); w.y = cvt_pk_bf16(y0[2], y0[3]); w.z = cvt_pk_bf16(y1[0], y1[1]); w.w = cvt_pk_bf16(y1[2], y1[3]);
                    *(u32x4*)(ho + 512 * j) = w; }
            } } }
    }
}

__device__ __forceinline__ void norm_phase(const bf16_t* mbuf, const float* ga, const float* xin, float* xout, const float* gb, bf16_t* hout, int gw, int NGW, int lane) {
    norm_phase_t<4>(mbuf, ga, xin, xout, gb, hout, gw, NGW, lane);
}
__device__ __forceinline__ TItem prep_decode(int it) {
    KArgs ap = kargs(); unsigned char* ws = ap->ws;
    constexpr int I_IN = 32 * 128, I_OAB = 32 * 64, I_QKV = 32 * 192, I_OC = 32 * 64, I_G = 32 * 176, I_D = 88 * 64;
    int r = it; TItem t; int mode;
    if (r < 2 * I_IN) { const int e = r / I_IN; r -= e * I_IN; t.W = ap->in[2] + (size_t)e * DM * IN_AB; t.WT = (bf16_t*)(ws + WS_WIN + e * SZ_WIN); t.K = DM; t.N = IN_AB; mode = 1; }
    else { r -= 2 * I_IN;
    if (r < 2 * I_OAB) { const int e = r / I_OAB; r -= e * I_OAB; t.W = ap->in[10] + (size_t)e * DM * DM; t.WT = (bf16_t*)(ws + WS_WOAB + e * SZ_WOAB); t.K = DM; t.N = DM; mode = 0; }
    else { r -= 2 * I_OAB;
    if (r < 2 * I_QKV) { const int e = r / I_QKV; r -= e * I_QKV; t.W = ap->in[11] + (size_t)e * DM * QKV_N; t.WT = (bf16_t*)(ws + WS_WQKV + e * SZ_WQKV); t.K = DM; t.N = QKV_N; mode = 0; }
    else { r -= 2 * I_QKV;
    if (r < 2 * I_OC) { const int e = r / I_OC; r -= e * I_OC; t.W = ap->in[14] + (size_t)e * DM * DM; t.WT = (bf16_t*)(ws + WS_WOC + e * SZ_WOC); t.K = DM; t.N = DM; mode = 0; }
    else { r -= 2 * I_OC;
        const int per = 2 * I_G + I_D; const int l = r / per; r -= l * per;
        if (r < I_G) { t.W = ap->in[16] + (size_t)l * DM * DFF; t.WT = (bf16_t*)(ws + WS_WGU + l * SZ_WGU); t.K = DM; t.N = DFF; mode = 2; }
        else if (r < 2 * I_G) { r -= I_G; t.W = ap->in[17] + (size_t)l * DM * DFF; t.WT = (bf16_t*)(ws + WS_WGU + l * SZ_WGU); t.K = DM; t.N = DFF; mode = 3; }
        else { r -= 2 * I_G; t.W = ap->in[18] + (size_t)l * DFF * DM; t.WT = (bf16_t*)(ws + WS_WDN + l * SZ_WDN); t.K = DFF; t.N = DM; mode = 0; }
    } } } }
    const int nblk = t.N / 32, kb = r / nblk, nb = r % nblk; t.k0 = 64 * kb; t.n0 = 32 * nb;
    const int n0 = t.n0; int drow0 = n0;
    if (mode == 1) { if (n0 < 1024) drow0 = (n0 >> 7) * 256 + (n0 & 127); else if (n0 < 2048) { const int ch = n0 - 1024; drow0 = (ch >> 7) * 256 + 128 + (ch & 127); } }
    else if (mode == 2) drow0 = (n0 >> 7) * 256 + (n0 & 127);
    else if (mode == 3) drow0 = (n0 >> 7) * 256 + 128 + (n0 & 127);
    t.drow0 = drow0; return t;
}
__device__ __forceinline__ void prep_phase(unsigned char* lds, int vcu, int G, const int wv) {
    KArgs ap = kargs();
    const int tid = otid(wv), wid = __builtin_amdgcn_readfirstlane(tid >> 6), lane = tid & 63;
    LAS float* scr = (LAS float*)(LAS unsigned char*)lds + wid * (64 * 33);
    const int gw = vcu * 8 + wid, NGW = G * 8;
    constexpr int I_IN = 32 * 128, I_OAB = 32 * 64, I_QKV = 32 * 192, I_OC = 32 * 64, I_G = 32 * 176, I_D = 88 * 64;
    constexpr int NITEMS = 2 * I_IN + 2 * I_OAB + 2 * I_QKV + 2 * I_OC + 4 * (2 * I_G + I_D);
    unsigned char* ws = ap->ws;
    int it = gw;
    if (it < NITEMS) {
        TItem cur = prep_decode(it); f32x4 v[8]; tile_load(cur, v, lane);
        for (;;) {
            const int nit = it + NGW; const bool has = nit < NITEMS; TItem nx = cur; f32x4 vn[8];
            if (has) { nx = prep_decode(nit); tile_load(nx, vn, lane); }
            tile_store(cur, v, scr, lane);
            if (!has) break;
            cur = nx; it = nit;
#pragma unroll
            for (int i = 0; i < 8; ++i) v[i] = vn[i];
        }
    }
    norm_phase(nullptr, nullptr, ap->in[0], nullptr, ap->in[1], (bf16_t*)(ws + WS_H), gw, NGW, lane);
}

__device__ __forceinline__ void conv_item(int it, const bf16_t* AG, const float* dw, const float* cg_, const float* cb_, bf16_t* CAT, unsigned char* lds, const int wv) {
    const int tid = otid(wv), wid = __builtin_amdgcn_readfirstlane(tid >> 6), lane = tid & 63;
    const int t0 = it * 32, b = t0 >> 12, s0 = t0 & 4095;
    LAS unsigned char* X = (LAS unsigned char*)lds;
    LAS f32x2* red = (LAS f32x2*)(X + 62 * 2048);
    LAS f32x2* stat = red + 256;
    __syncthreads();
#pragma unroll
    for (int p = 0; p < 16; ++p) { const int r = p * 4 + (tid >> 7);
        if (r < 62) { const int sp = s0 - 15 + r; u32x4 val = {0u, 0u, 0u, 0u};
            if (sp >= 0 && sp < SEQ) val = *(const u32x4*)(AG + ((size_t)(b * SEQ + sp)) * 1024 + 8 * (tid & 127));
            *(LAS u32x4*)(X + r * 2048 + 16 * (tid & 127)) = val; } }
    __syncthreads();
    f32x2 wt[CONV_W];
#pragma unroll
    for (int j = 0; j < CONV_W; ++j) wt[j] = *(const f32x2*)(dw + j * 1024 + 2 * tid);
    f32x2 accv[32];
#pragma unroll
    for (int tt = 0; tt < 32; ++tt) accv[tt] = (f32x2){0.f, 0.f};
    const LAS unsigned* X32 = (const LAS unsigned*)X;
#pragma unroll
    for (int r = 0; r < 62; ++r) {
        const unsigned v = X32[r * 512 + tid]; const f32x2 xf = {bf_lo(v), bf_hi(v)};
#pragma unroll
        for (int tt = (r > 30 ? r - 30 : 0); tt <= (r < 31 ? r : 31); ++tt) accv[tt] = accv[tt] + xf * wt[r - tt];
    }
    float acc[32][2];
#pragma unroll
    for (int tt = 0; tt < 32; ++tt) { acc[tt][0] = accv[tt].x; acc[tt][1] = accv[tt].y; }
#pragma unroll
    for (int tt = 0; tt < 32; ++tt) {
        float s1 = acc[tt][0] + acc[tt][1], s2 = acc[tt][0] * acc[tt][0] + acc[tt][1] * acc[tt][1];
        s1 = wave_sum(s1); s2 = wave_sum(s2);
        if (lane == 0) red[tt * 8 + wid] = (f32x2){s1, s2};
    }
    __syncthreads();
    if (tid < 32) { float s1 = 0.f, s2 = 0.f;
#pragma unroll
        for (int w = 0; w < 8; ++w) { const f32x2 v = red[tid * 8 + w]; s1 += v.x; s2 += v.y; }
        const float mean = s1 * (1.0f / 1024.0f); float var = s2 * (1.0f / 1024.0f) - mean * mean; var = var < 0.f ? 0.f : var;
        stat[tid] = (f32x2){mean, 1.0f / sqrtf(var + EPS)}; }
    __syncthreads();
    const f32x2 g = *(const f32x2*)(cg_ + 2 * tid), bb = *(const f32x2*)(cb_ + 2 * tid);
#pragma unroll
    for (int tt = 0; tt < 32; ++tt) { const f32x2 st = stat[tt];
        float y0 = (acc[tt][0] - st.x) * st.y * g.x + bb.x, y1 = (acc[tt][1] - st.x) * st.y * g.y + bb.y;
        y0 = y0 * sigmoid_f(y0); y1 = y1 * sigmoid_f(y1);
        ((LAS unsigned*)X)[tt * 512 + tid] = cvt_pk_bf16(y0, y1); }
    __syncthreads();
#pragma unroll
    for (int j = 0; j < 8; ++j) { const int c = tid + 512 * j, row = c >> 7, col16 = c & 127;
        const u32x4 v = *(const LAS u32x4*)(X + row * 2048 + col16 * 16);
        *(u32x4*)(CAT + (size_t)(t0 + row) * DM + col16 * 8) = v; }
}

__device__ __forceinline__ void sgu_item(int it, const bf16_t* GV, const bf16_t* ZU, const float* sg_, const float* sb_, const float* wsp, const float* bsp, bf16_t* CAT, unsigned char* lds, const int wv) {
    const int tid = otid(wv), wid = __builtin_amdgcn_readfirstlane(tid >> 6), lane = tid & 63;
    const int chunk = it >> 2, gp = it & 3, tok0 = chunk * 128;
    LAS unsigned char* ZT = (LAS unsigned char*)lds;
    __syncthreads();
    {
        float mean[16], rstd[16];
#pragma unroll
        for (int i = 0; i < 16; ++i) { const bf16_t* row = GV + (size_t)(tok0 + 16 * wid + i) * 1024;
            const u32x4 a = *(const u32x4*)(row + 8 * lane), c = *(const u32x4*)(row + 512 + 8 * lane);
            float v[16];
#pragma unroll
            for (int k = 0; k < 4; ++k) { v[2 * k] = bf_lo(a[k]); v[2 * k + 1] = bf_hi(a[k]); v[8 + 2 * k] = bf_lo(c[k]); v[8 + 2 * k + 1] = bf_hi(c[k]); }
            float s = 0.f;
#pragma unroll
            for (int k = 0; k < 16; ++k) s += v[k];
            const float mu = wave_sum(s) * (1.0f / 1024.0f); float q = 0.f;
#pragma unroll
            for (int k = 0; k < 16; ++k) { const float d = v[k] - mu; q += d * d; }
            mean[i] = mu; rstd[i] = 1.0f / sqrtf(wave_sum(q) * (1.0f / 1024.0f) + EPS); }
#pragma unroll
        for (int gg = 0; gg < 2; ++gg) {
            const int c0 = (2 * gp + gg) * 128 + 2 * lane;
            const f32x2 sgv = *(const f32x2*)(sg_ + c0), sbv = *(const f32x2*)(sb_ + c0);
            float z0[16], z1[16];
#pragma unroll
            for (int i = 0; i < 16; ++i) { const unsigned v = *(const unsigned*)(GV + (size_t)(tok0 + 16 * wid + i) * 1024 + c0);
                z0[i] = (bf_lo(v) - mean[i]) * rstd[i] * sgv.x + sbv.x; z1[i] = (bf_hi(v) - mean[i]) * rstd[i] * sgv.y + sbv.y; }
            u32x4 w0a, w0b, w1a, w1b;
            w0a.x = cvt_pk_bf16(z0[0], z0[1]); w0a.y = cvt_pk_bf16(z0[2], z0[3]); w0a.z = cvt_pk_bf16(z0[4], z0[5]); w0a.w = cvt_pk_bf16(z0[6], z0[7]);
            w0b.x = cvt_pk_bf16(z0[8], z0[9]); w0b.y = cvt_pk_bf16(z0[10], z0[11]); w0b.z = cvt_pk_bf16(z0[12], z0[13]); w0b.w = cvt_pk_bf16(z0[14], z0[15]);
            w1a.x = cvt_pk_bf16(z1[0], z1[1]); w1a.y = cvt_pk_bf16(z1[2], z1[3]); w1a.z = cvt_pk_bf16(z1[4], z1[5]); w1a.w = cvt_pk_bf16(z1[6], z1[7]);
            w1b.x = cvt_pk_bf16(z1[8], z1[9]); w1b.y = cvt_pk_bf16(z1[10], z1[11]); w1b.z = cvt_pk_bf16(z1[12], z1[13]); w1b.w = cvt_pk_bf16(z1[14], z1[15]);
            LAS unsigned char* r0 = ZT + gg * 34816 + (2 * lane) * 272 + 32 * wid;
            *(LAS u32x4*)(r0) = w0a; *(LAS u32x4*)(r0 + 16) = w0b; *(LAS u32x4*)(r0 + 272) = w1a; *(LAS u32x4*)(r0 + 272 + 16) = w1b;
        }
    }
    __syncthreads();
    const int pl = lane & 15, kg = lane >> 4, p = 16 * wid + pl;
#pragma unroll 1
    for (int gg = 0; gg < 2; ++gg) {
        const int g = 2 * gp + gg;
        bf16x8 Y[4];
#pragma unroll
        for (int ks = 0; ks < 4; ++ks) { const float* wp = wsp + ((size_t)g * 128 + p) * 128 + 32 * ks + 8 * kg;
            const f32x4 a = *(const f32x4*)wp, c = *(const f32x4*)(wp + 4);
            u32x4 w; w.x = cvt_pk_bf16(a[0], a[1]); w.y = cvt_pk_bf16(a[2], a[3]); w.z = cvt_pk_bf16(c[0], c[1]); w.w = cvt_pk_bf16(c[2], c[3]);
            Y[ks] = *reinterpret_cast<bf16x8*>(&w); }
        f32x4 acc[8];
#pragma unroll
        for (int ct = 0; ct < 8; ++ct) { acc[ct] = (f32x4){0.f, 0.f, 0.f, 0.f};
#pragma unroll
            for (int ks = 0; ks < 4; ++ks) { const bf16x8 X = *(const LAS bf16x8*)(ZT + gg * 34816 + (16 * ct + pl) * 272 + 64 * ks + 16 * kg);
                acc[ct] = __builtin_amdgcn_mfma_f32_16x16x32_bf16(X, Y[ks], acc[ct], 0, 0, 0); } }
        const float bs = bsp[g * 128 + p]; const size_t tok = (size_t)(tok0 + p);
#pragma unroll
        for (int ct = 0; ct < 8; ++ct) { const int c = g * 128 + 16 * ct + 4 * kg;
            const u32x2 zu = *(const u32x2*)(ZU + tok * 1024 + c);
            const float o0 = bf_lo(zu.x) * (acc[ct][0] + bs), o1 = bf_hi(zu.x) * (acc[ct][1] + bs), o2 = bf_lo(zu.y) * (acc[ct][2] + bs), o3 = bf_hi(zu.y) * (acc[ct][3] + bs);
            u32x2 w; w.x = cvt_pk_bf16(o0, o1); w.y = cvt_pk_bf16(o2, o3);
            *(u32x2*)(CAT + tok * DM + 1024 + c) = w; }
    }
}

__device__ __forceinline__ int t5_bucket(int rel) {
    const int n = rel < 0 ? -rel : rel; int v;
    if (n < 8) v = n; else if (n < 12) v = 8; else if (n < 16) v = 9; else if (n < 23) v = 10; else if (n < 32) v = 11; else if (n < 46) v = 12; else if (n < 64) v = 13; else if (n < 91) v = 14; else v = 15;
    return (rel > 0 ? 16 : 0) + v;
}

__device__ __forceinline__ void attn_item(int it, int layer, const bf16_t* QKV, float* SCR, bf16_t* OB, unsigned char* lds, const int wv) {
    const int tid = otid(wv), wid = __builtin_amdgcn_readfirstlane(tid >> 6), lane = tid & 63;
    const int o = layer >> 1;
    const int b = it >> 7, h = (it >> 4) & 7, qb = it & 15;
    const float lambda_init = 0.8f - 0.6f * expf(-0.3f * (float)layer);
    float lam;
    { const float* lq = kargs()->in[12] + (size_t)o * 4 * 128;
      float d1 = lq[lane] * lq[128 + lane] + lq[64 + lane] * lq[128 + 64 + lane], d2 = lq[256 + lane] * lq[384 + lane] + lq[256 + 64 + lane] * lq[384 + 64 + lane];
      d1 = wave_sum(d1); d2 = wave_sum(d2); lam = expf(d1) - expf(d2) + lambda_init; lam = __uint_as_float(__builtin_amdgcn_readfirstlane(__float_as_uint(lam))); }
    __syncthreads();
    LAS float* tab = (LAS float*)(LAS unsigned char*)(lds + att::OFF_TAB);
    if (tid < 385) tab[tid] = kargs()->in[15][t5_bucket(tid - 192) * 8 + h];
    __syncthreads();
    const size_t row0 = (size_t)b * SEQ + (size_t)qb * 256;
    const bf16_t* Qrow = QKV + row0 * QKV_N + h * 256;
    const bf16_t* Kb = QKV + (size_t)b * SEQ * QKV_N + 2048 + h * 256;
    const bf16_t* Vb = QKV + (size_t)b * SEQ * QKV_N + 4096 + h * 256;
    float* Ob = SCR + row0 * DM + h * 256;
#pragma unroll 1
    for (int c = 0; c < 2; ++c) {
        __syncthreads();
        att::attn_pass(Qrow + c * 128, Kb + c * 128, Vb, Ob, c, lam, qb * 256, SEQ, (char*)lds, wv);
    }
    {
        const int tid2 = otid(wv), lane2 = tid2 & 63, wid2 = __builtin_amdgcn_readfirstlane(tid2 >> 6);
        const int srow = lane2 >> 5, sc4 = (lane2 & 31) * 4;
        const float sc1 = 1.0f - (0.8f - 0.6f * expf(-0.3f * (float)layer));
        const float* gsub = kargs()->in[13] + (size_t)o * 256;
        const f32x4 g0 = *(const f32x4*)(gsub + sc4) * sc1, g1 = *(const f32x4*)(gsub + 128 + sc4) * sc1;
        const float* src = Ob + (size_t)(wid2 * 32 + srow) * DM + sc4;
        bf16_t* dst = OB + (row0 + wid2 * 32 + srow) * DM + h * 256 + sc4;
#pragma unroll 8
        for (int k = 0; k < 16; ++k) {
            const f32x4 a = *(const f32x4*)src, c = *(const f32x4*)(src + 128);
            float ss = ((a[0] * a[0] + a[1] * a[1]) + (a[2] * a[2] + a[3] * a[3])) + ((c[0] * c[0] + c[1] * c[1]) + (c[2] * c[2] + c[3] * c[3]));
            ss += DPP_F(ss, 0xB1); ss += DPP_F(ss, 0x4E); ss += DPP_F(ss, 0x141); ss += DPP_F(ss, 0x140); ss += SWZ_XOR(ss, 16);
            const float rr = 1.0f / sqrtf(ss * (1.0f / 256.0f) + EPS);
            const f32x4 y0 = a * rr * g0, y1 = c * rr * g1;
            u32x2 w0, w1; w0.x = cvt_pk_bf16(y0[0], y0[1]); w0.y = cvt_pk_bf16(y0[2], y0[3]); w1.x = cvt_pk_bf16(y1[0], y1[1]); w1.y = cvt_pk_bf16(y1[2], y1[3]);
            *(u32x2*)dst = w0; *(u32x2*)(dst + 128) = w1;
            src += 2 * DM; dst += 2 * DM;
        }
    }
}

constexpr int N_PHASES = 1 + 7 * DEPTH;
__global__ void __launch_bounds__(512, 2) mega(Args a_unused) {
    extern __shared__ __attribute__((aligned(16))) unsigned char lds[];
    const int wv = __builtin_amdgcn_readfirstlane(threadIdx.x >> 6);
    const int lo = kargs()->lo;
#pragma unroll 1
    for (int ph = lo; ph < kargs()->hi; ++ph) {
        KArgs ap = kargs();
        const int G = gridDim.x, bx = blockIdx.x;
        const int vcu = (G % 8 == 0) ? (bx % 8) * (G / 8) + bx / 8 : bx;
        unsigned char* ws = ap->ws;
        bf16_t* H = (bf16_t*)(ws + WS_H);
        unsigned char* BIG = ws + WS_BIG;
        float* MBUF = (float*)(ws + WS_MBUF);
        const int tid = otid(wv), wid = __builtin_amdgcn_readfirstlane(tid >> 6), lane = tid & 63;
        const int gw = vcu * 8 + wid, NGW = G * 8;
        if (ph == 0) {
#ifndef NO_PREP
            prep_phase(lds, vcu, G, wv);
#endif
        } else {
            const int l = (ph - 1) / 7, s = (ph - 1) % 7, e = l >> 1;
            const bool even = (l & 1) == 0;
            if (s == 0) {
                if (even) { pg8::Gemm g{H, (const bf16_t*)(ws + WS_WIN + e * SZ_WIN), M_TOK, IN_AB, DM}; pg8::StaticOrder S; S.init(M_TOK, IN_AB, G, bx);
                    pg8::EpiGemm1 E{(bf16_t*)(BIG + BIG_AG), (bf16_t*)(BIG + BIG_ZU), (bf16_t*)(BIG + BIG_GV)};
#ifndef NO_G1
                    pg8::gemm_phase<pg8::EpiGemm1, pg8::StaticOrder>((LAS unsigned char*)lds, g, S, E, wv);
#endif
                } else { pg8::Gemm g{H, (const bf16_t*)(ws + WS_WQKV + e * SZ_WQKV), M_TOK, QKV_N, DM}; pg8::StaticOrder S; S.init(M_TOK, QKV_N, G, bx);
                    pg8::EpiQKV E{(bf16_t*)(BIG + BIG_QKV), QKV_N, 8};
#ifndef NO_GQKV
                    pg8::gemm_phase<pg8::EpiQKV, pg8::StaticOrder>((LAS unsigned char*)lds, g, S, E, wv);
#endif
                }
            } else if (s == 1) {
                if (even) {
#ifndef NO_CONV
                    for (int it = vcu; it < 512; it += G)
                        conv_item(it, (const bf16_t*)(BIG + BIG_AG), ap->in[3] + (size_t)e * CONV_W * 1024, ap->in[4] + e * 1024, ap->in[5] + e * 1024, (bf16_t*)(BIG + BIG_CAT), lds, wv);
#endif
#ifndef NO_SGU
                    for (int it = vcu; it < 512; it += G)
                        sgu_item(it, (const bf16_t*)(BIG + BIG_GV), (const bf16_t*)(BIG + BIG_ZU), ap->in[6] + e * 1024, ap->in[7] + e * 1024, ap->in[8] + (size_t)e * 8 * 128 * 128, ap->in[9] + e * 8 * 128, (bf16_t*)(BIG + BIG_CAT), lds, wv);
#endif
                } else {
#ifndef NO_ATT
                    for (int it = vcu; it < 512; it += G)
                        attn_item(it, l, (const bf16_t*)(BIG + BIG_QKV), MBUF, (bf16_t*)(BIG + BIG_OB), lds, wv);
#endif
                }
            } else if (s == 2 || s == 5) {
                const bf16_t* A; const bf16_t* Bt; int K;
                if (s == 2) { K = DM; if (even) { A = (const bf16_t*)(BIG + BIG_CAT); Bt = (const bf16_t*)(ws + WS_WOAB + e * SZ_WOAB); } else { A = (const bf16_t*)(BIG + BIG_OB); Bt = (const bf16_t*)(ws + WS_WOC + e * SZ_WOC); } }
                else { K = DFF; A = (const bf16_t*)(BIG + BIG_ACT); Bt = (const bf16_t*)(ws + WS_WDN + l * SZ_WDN); }
                pg8::Gemm g{A, Bt, M_TOK, DM, K}; pg8::StaticOrder S; S.init(M_TOK, DM, G, bx);
                pg8::EpiQKV E{(bf16_t*)MBUF, DM, 0};
#ifndef NO_GF32
                pg8::gemm_phase<pg8::EpiQKV, pg8::StaticOrder>((LAS unsigned char*)lds, g, S, E, wv);
#endif
            } else if (s == 3) {
                const float* xin = (l == 0) ? ap->in[0] : ap->out;
                norm_phase((const bf16_t*)MBUF, ap->in[1] + (size_t)(l * 4 + 1) * DM, xin, ap->out, ap->in[1] + (size_t)(l * 4 + 2) * DM, H, gw, NGW, lane);
            } else if (s == 4) {
                pg8::Gemm g{H, (const bf16_t*)(ws + WS_WGU + l * SZ_WGU), M_TOK, 2 * DFF, DM}; pg8::StaticOrder S; S.init(M_TOK, 2 * DFF, G, bx);
                pg8::EpiSwiGLU E{(bf16_t*)(BIG + BIG_ACT), DFF};
#ifndef NO_GSW
                pg8::gemm_phase<pg8::EpiSwiGLU, pg8::StaticOrder>((LAS unsigned char*)lds, g, S, E, wv);
#endif
            } else {
                const bool lastl = (l == DEPTH - 1);
                norm_phase((const bf16_t*)MBUF, ap->in[1] + (size_t)(l * 4 + 3) * DM, ap->out, ap->out, lastl ? nullptr : ap->in[1] + (size_t)((l + 1) * 4 + 0) * DM, lastl ? nullptr : H, gw, NGW, lane);
            }
        }
        if (ph + 1 < kargs()->hi) { if (kargs()->coop) cg::this_grid().sync(); }
    }
}

extern "C" void kernel_launch(void* const* d_in, const int* in_sizes, int n_in, void* d_out, int out_size, void* d_ws, size_t ws_size, hipStream_t stream) {
    static int grid = 0;
    if (grid == 0) {
        if (n_in != 19 || in_sizes[0] != M_TOK * DM || out_size != M_TOK * DM || ws_size < WS_END) {
            fprintf(stderr, "kernel_launch: shape mismatch n_in %d in0 %d out %d ws %zu (need %zu)\n", n_in, n_in > 0 ? in_sizes[0] : -1, out_size, ws_size, (size_t)WS_END); grid = -1; return; }
        int dev = 0, cus = 0, per_cu = 0;
        if (hipGetDevice(&dev) != hipSuccess || hipDeviceGetAttribute(&cus, hipDeviceAttributeMultiprocessorCount, dev) != hipSuccess) { grid = -1; return; }
        if (hipFuncSetAttribute((const void*)mega, hipFuncAttributeMaxDynamicSharedMemorySize, LDS_BYTES) != hipSuccess) { fprintf(stderr, "kernel_launch: hipFuncSetAttribute failed\n"); grid = -1; return; }
        if (hipOccupancyMaxActiveBlocksPerMultiprocessor(&per_cu, (const void*)mega, 512, LDS_BYTES) != hipSuccess || per_cu < 1) { fprintf(stderr, "kernel_launch: occupancy query says %d\n", per_cu); per_cu = 1; }
        (void)hipGetLastError();
        grid = cus * 1;
        (void)per_cu;
    }
    if (grid < 0) return;
    Args a{};
    for (int i = 0; i < 19; ++i) a.in[i] = (const float*)d_in[i];
    a.out = (float*)d_out; a.ws = (unsigned char*)d_ws;
#if N_LAUNCH_MODE == 1
    for (int ph = 0; ph < N_PHASES; ++ph) { a.lo = ph; a.hi = ph + 1; a.coop = 0; a.pad = 0;
        int ptype = 0;
        if (ph > 0) { const int l_ = (ph - 1) / 7, s_ = (ph - 1) % 7; ptype = (s_ == 0) ? 1 : (s_ == 1) ? (((l_ & 1) == 0) ? 2 : 3) : (s_ == 2 || s_ == 5) ? 4 : (s_ == 4) ? 5 : 6; }
        const int nrep = ((DUP_MASK >> ptype) & 1) ? 2 : 1;
        for (int rep = 0; rep < nrep; ++rep) hipLaunchKernelGGL(mega, dim3(grid), dim3(512), LDS_BYTES, stream, a); }
#else
    a.lo = 0; a.hi = N_PHASES; a.coop = 1; a.pad = 0;
    void* args[] = {&a};
    hipError_t e = hipLaunchCooperativeKernel((const void*)mega, dim3(grid), dim3(512), args, LDS_BYTES, stream);
    if (e != hipSuccess) fprintf(stderr, "kernel_launch: cooperative launch failed: %s (grid %d)\n", hipGetErrorString(e), grid);
#endif
}
```

```cpp
#include <hip/hip_runtime.h>
#include <hip/hip_cooperative_groups.h>
#include <cstdio>
#include <cstdint>
namespace cg = cooperative_groups;

#ifndef N_LAUNCH_MODE
#define N_LAUNCH_MODE 0
#endif

#ifndef DUP_MASK
#define DUP_MASK 0
#endif
#define LAS __attribute__((address_space(3)))
typedef unsigned short bf16_t;
typedef short bf16x8 __attribute__((ext_vector_type(8)));
typedef short s16x4 __attribute__((ext_vector_type(4)));
typedef float f32x2 __attribute__((ext_vector_type(2)));
typedef float f32x4 __attribute__((ext_vector_type(4)));
typedef float f32x16 __attribute__((ext_vector_type(16)));
typedef unsigned u32x2 __attribute__((ext_vector_type(2)));
typedef unsigned u32x4 __attribute__((ext_vector_type(4)));

constexpr int M_TOK = 16384, DM = 2048, SEQ = 4096, NBATCH = 4, DFF = 5632, DEPTH = 4;
constexpr int CONV_CH = 1024, CONV_W = 31, SGU_CH = 1024;
constexpr int IN_AB = 4096, QKV_N = 6144;
constexpr float EPS = 1e-6f;
constexpr float LOG2E = 1.4426950408889634f;

constexpr size_t SZ_WIN = (size_t)IN_AB * DM * 2, SZ_WOAB = (size_t)DM * DM * 2, SZ_WQKV = (size_t)QKV_N * DM * 2, SZ_WOC = (size_t)DM * DM * 2;
constexpr size_t SZ_WGU = (size_t)2 * DFF * DM * 2, SZ_WDN = (size_t)DM * DFF * 2;
constexpr size_t WS_WIN = 0, WS_WOAB = WS_WIN + 2 * SZ_WIN, WS_WQKV = WS_WOAB + 2 * SZ_WOAB, WS_WOC = WS_WQKV + 2 * SZ_WQKV;
constexpr size_t WS_WGU = WS_WOC + 2 * SZ_WOC, WS_WDN = WS_WGU + 4 * SZ_WGU, WS_H = WS_WDN + 4 * SZ_WDN;
constexpr size_t WS_BIG = WS_H + (size_t)M_TOK * DM * 2;
constexpr size_t SZ_BIG = (size_t)M_TOK * (QKV_N + DM) * 2;
constexpr size_t WS_MBUF = WS_BIG + SZ_BIG;
constexpr size_t WS_END = WS_MBUF + (size_t)M_TOK * DM * 4;
constexpr size_t BIG_AG = 0, BIG_ZU = (size_t)M_TOK * 1024 * 2, BIG_GV = 2 * BIG_ZU, BIG_CAT = 3 * BIG_ZU;
constexpr size_t BIG_QKV = 0, BIG_OB = (size_t)M_TOK * QKV_N * 2;
constexpr size_t BIG_ACT = 0;

constexpr int LDS_BYTES = 151552;

__device__ __forceinline__ unsigned cvt_pk_bf16(float lo, float hi) { unsigned r; asm volatile("v_cvt_pk_bf16_f32 %0, %1, %2" : "=v"(r) : "v"(lo), "v"(hi)); return r; }
__device__ __forceinline__ float bf_lo(unsigned v) { return __uint_as_float(v << 16); }
__device__ __forceinline__ float bf_hi(unsigned v) { return __uint_as_float(v & 0xffff0000u); }
__device__ __forceinline__ int otid(int wv) { int l; asm volatile("v_mbcnt_lo_u32_b32 %0, -1, 0\n\tv_mbcnt_hi_u32_b32 %0, -1, %0" : "=v"(l)); return wv * 64 + l; }
#define SWZ_XOR(v, k) __int_as_float(__builtin_amdgcn_ds_swizzle(__float_as_int(v), ((k) << 10) | 0x1f))
#define DPP_F(v, ctrl) __int_as_float(__builtin_amdgcn_update_dpp(0, __float_as_int(v), (ctrl), 0xf, 0xf, false))
__device__ __forceinline__ float wave_sum(float v) {
    v += DPP_F(v, 0xB1); v += DPP_F(v, 0x4E); v += DPP_F(v, 0x141); v += DPP_F(v, 0x140); v += SWZ_XOR(v, 16);
    auto rr = __builtin_amdgcn_permlane32_swap(__float_as_uint(v), __float_as_uint(v), false, false);
    return __uint_as_float(rr[0]) + __uint_as_float(rr[1]);
}
__device__ __forceinline__ float sigmoid_f(float x) { return __builtin_amdgcn_rcpf(1.0f + __builtin_amdgcn_exp2f(-x * LOG2E)); }
__device__ __forceinline__ f32x2 gelu_pk(f32x2 v) {
    const f32x2 av = __builtin_elementwise_abs(v), d = av * 0.2316418882f + 1.0f;
    f32x2 t; t.x = __builtin_amdgcn_rcpf(d.x); t.y = __builtin_amdgcn_rcpf(d.y);
    f32x2 q = t * 0.5307027145f + (-0.7265760135f); q = q * t + 0.7107068705f; q = q * t + (-0.142248368f); q = q * t + 0.127414796f; q = q * t;
    const f32x2 s = (v * v) * (-0.72134752044f);
    f32x2 e; e.x = __builtin_amdgcn_exp2f(s.x); e.y = __builtin_amdgcn_exp2f(s.y);
    const f32x2 m = v * (q * e), r = v - m;
    f32x2 o; o.x = v.x < 0.f ? m.x : r.x; o.y = v.y < 0.f ? m.y : r.y; return o;
}

namespace pg8 {
constexpr int BM = 256, BK = 64, HALF = 128, HTB = HALF * BK * 2, STAGE_BYTES = 8 * HTB, NXCD = 8, WGM = 4;
__host__ __device__ __forceinline__ int lds_byte(int r, int c) { const int st = (r >> 4) * 2 + (c >> 5), rr = r & 15, cc = c & 31, ob = rr * 64 + cc * 2; return st * 1024 + (ob ^ (((ob >> 9) & 1) << 5)); }
__host__ __device__ __forceinline__ void stage_rc(int b, int& R, int& C) { const int st = b / 1024, sb = b % 1024, swz = sb ^ (((sb >> 9) & 1) << 5); R = (st >> 1) * 16 + swz / 64; C = (st & 1) * 32 + (swz % 64) / 2; }
__host__ __device__ __forceinline__ int perm32(int rho) { const int n = rho >> 4, i = rho & 15; return 8 * (i >> 2) + 4 * n + (i & 3); }

struct Unit { int pm, pn; };
struct Gemm { const bf16_t* A; const bf16_t* Bt; int M, N, K; };
struct StaticOrder {
    int nM, nN, nwg, G, c;
    __device__ void init(int M, int N, int G_, int c_) { nM = M / BM; nN = N / BM; nwg = nM * nN; G = G_; c = c_; }
    __device__ bool next(int i, Unit& u) const {
        const long L = (long)i * G + c; if (L >= nwg) return false;
        int wgid = (int)L; { const int q = nwg / NXCD, r = nwg % NXCD, xcd = wgid % NXCD, off = wgid / NXCD; wgid = (xcd < r ? xcd * (q + 1) : r * (q + 1) + (xcd - r) * q) + off; }
        const int nig = WGM * nN, gid = wgid / nig, fm = gid * WGM, gsz = (nM - fm) < WGM ? (nM - fm) : WGM;
        u.pm = fm + ((wgid % nig) % gsz); u.pn = (wgid % nig) / gsz; return true;
    }
    __device__ __forceinline__ void a_ready(const Unit&) const {}
    __device__ __forceinline__ void done(const Unit&) const {}
};

struct EpiF32 {
    static constexpr bool PERM = false, AFTER_DRAIN = false;
    float* C; int ldc;
    __device__ __forceinline__ void operator()(const f32x4 (&acc)[2][2][4][2], const Unit& u, int wr, int wc, int fr, int fq) const {
        const int row0 = u.pm * BM + wr * 64 + fr, col0 = u.pn * BM + wc * 32 + 4 * fq;
#pragma unroll
        for (int ai = 0; ai < 2; ++ai)
#pragma unroll
            for (int m = 0; m < 4; ++m) { float* rowp = C + (size_t)(row0 + ai * HALF + m * 16) * ldc + col0;
#pragma unroll
                for (int bj = 0; bj < 2; ++bj)
#pragma unroll
                    for (int n = 0; n < 2; ++n) *(f32x4*)(rowp + bj * HALF + n * 16) = acc[ai][bj][m][n]; }
    }
};
struct EpiQKV {
    static constexpr bool PERM = true, AFTER_DRAIN = false;
    bf16_t* O; int ldc; int qtiles;
    __device__ __forceinline__ void operator()(const f32x4 (&acc)[2][2][4][2], const Unit& u, int wr, int wc, int fr, int fq) const {
        const int row0 = u.pm * BM + wr * 64 + fr, col0 = u.pn * BM + wc * 32 + 8 * fq;
        const float sc = (u.pn < qtiles) ? 0.08838834764831845f : 1.0f;
#pragma unroll
        for (int ai = 0; ai < 2; ++ai)
#pragma unroll
            for (int m = 0; m < 4; ++m) { bf16_t* rowp = O + (size_t)(row0 + ai * HALF + m * 16) * ldc + col0;
#pragma unroll
                for (int bj = 0; bj < 2; ++bj) { const f32x4 v0 = acc[ai][bj][m][0] * sc, v1 = acc[ai][bj][m][1] * sc;
                    u32x4 w; w.x = cvt_pk_bf16(v0[0], v0[1]); w.y = cvt_pk_bf16(v0[2], v0[3]); w.z = cvt_pk_bf16(v1[0], v1[1]); w.w = cvt_pk_bf16(v1[2], v1[3]);
                    *(u32x4*)(rowp + bj * HALF) = w; } }
    }
};
struct EpiSwiGLU {
    static constexpr bool PERM = true, AFTER_DRAIN = false;
    bf16_t* O; int ldc;
    __device__ __forceinline__ void operator()(const f32x4 (&acc)[2][2][4][2], const Unit& u, int wr, int wc, int fr, int fq) const {
        const int row0 = u.pm * BM + wr * 64 + fr, col0 = u.pn * HALF + wc * 32 + 8 * fq;
#pragma unroll
        for (int ai = 0; ai < 2; ++ai)
#pragma unroll
            for (int m = 0; m < 4; ++m) { bf16_t* rowp = O + (size_t)(row0 + ai * HALF + m * 16) * ldc + col0;
                float v[8];
#pragma unroll
                for (int n = 0; n < 2; ++n)
#pragma unroll
                    for (int j = 0; j < 4; ++j) { const float g = acc[ai][0][m][n][j], up = acc[ai][1][m][n][j]; v[n * 4 + j] = g * sigmoid_f(g) * up; }
                u32x4 w; w.x = cvt_pk_bf16(v[0], v[1]); w.y = cvt_pk_bf16(v[2], v[3]); w.z = cvt_pk_bf16(v[4], v[5]); w.w = cvt_pk_bf16(v[6], v[7]);
                *(u32x4*)rowp = w; }
    }
};
struct EpiGemm1 {
    static constexpr bool PERM = true, AFTER_DRAIN = false;
    bf16_t* AG; bf16_t* ZU; bf16_t* GV;
    __device__ __forceinline__ void operator()(const f32x4 (&acc)[2][2][4][2], const Unit& u, int wr, int wc, int fr, int fq) const {
        const int row0 = u.pm * BM + wr * 64 + fr;
        if (u.pn < 8) {
            const int col0 = u.pn * HALF + wc * 32 + 8 * fq;
#pragma unroll
            for (int ai = 0; ai < 2; ++ai)
#pragma unroll
                for (int m = 0; m < 4; ++m) { bf16_t* rowp = AG + (size_t)(row0 + ai * HALF + m * 16) * 1024 + col0;
                    float v[8];
#pragma unroll
                    for (int n = 0; n < 2; ++n)
#pragma unroll
                        for (int j = 0; j < 4; ++j) v[n * 4 + j] = acc[ai][0][m][n][j] * sigmoid_f(acc[ai][1][m][n][j]);
                    u32x4 w; w.x = cvt_pk_bf16(v[0], v[1]); w.y = cvt_pk_bf16(v[2], v[3]); w.z = cvt_pk_bf16(v[4], v[5]); w.w = cvt_pk_bf16(v[6], v[7]);
                    *(u32x4*)rowp = w; }
        } else {
            bf16_t* O = (u.pn < 12) ? ZU : GV; const int col0 = ((u.pn - 8) & 3) * BM + wc * 32 + 8 * fq;
#pragma unroll
            for (int ai = 0; ai < 2; ++ai)
#pragma unroll
                for (int m = 0; m < 4; ++m) { bf16_t* rowp = O + (size_t)(row0 + ai * HALF + m * 16) * 1024 + col0;
#pragma unroll
                    for (int bj = 0; bj < 2; ++bj) { const f32x4 v0 = acc[ai][bj][m][0], v1 = acc[ai][bj][m][1];
                        const f32x2 a = gelu_pk((f32x2){v0[0], v0[1]}), b = gelu_pk((f32x2){v0[2], v0[3]}), c = gelu_pk((f32x2){v1[0], v1[1]}), d = gelu_pk((f32x2){v1[2], v1[3]});
                        u32x4 w; w.x = cvt_pk_bf16(a.x, a.y); w.y = cvt_pk_bf16(b.x, b.y); w.z = cvt_pk_bf16(c.x, c.y); w.w = cvt_pk_bf16(d.x, d.y);
                        *(u32x4*)(rowp + bj * HALF) = w; } }
        }
    }
};

template <class Epi, class Sched>
__device__ __forceinline__ void gemm_phase(LAS unsigned char* lds, const Gemm g, const Sched& S, const Epi& E, const int wv) {
    const int tid = otid(wv), wid = __builtin_amdgcn_readfirstlane(tid >> 6), lane = tid & 63, wr = wid >> 2, wc = wid & 3, fr = lane & 15, fq = lane >> 4;
    const int K = g.K, nt = K / BK;
    unsigned voffA[2], voffB[2];
#pragma unroll
    for (int i = 0; i < 2; ++i) { int R, C; stage_rc(tid * 16 + i * 8192, R, C); const int Rb = Epi::PERM ? ((R & ~31) + perm32(R & 31)) : R;
        voffA[i] = (unsigned)(R * K + C) * 2u; voffB[i] = (unsigned)(Rb * K + C) * 2u; }
    const size_t kstep = (size_t)(BK * 2);
    const size_t hstep = (size_t)HALF * K * 2;
    const size_t tstep = 2 * hstep;
    const unsigned ldsw = (unsigned)wid * 1024u;
    const int aoff = lds_byte(wr * 64 + fr, fq * 8), boff = lds_byte(wc * 32 + fr, fq * 8);
#define PG8_SA(b, h) (((b) * 2 + (h)) * HTB)
#define PG8_SB(b, h) ((4 + (b) * 2 + (h)) * HTB)
#define PG8_STAGE(bufoff, gbase, voff) do { _Pragma("unroll") for (int _i = 0; _i < 2; ++_i) \
        __builtin_amdgcn_global_load_lds((const unsigned*)((const char*)(gbase) + (voff)[_i]), (LAS unsigned*)(lds + (bufoff) + ldsw + _i * 8192), 16, 0, 0); } while (0)
#define PG8_LDA(dst, b, h) do { _Pragma("unroll") for (int m = 0; m < 4; ++m) _Pragma("unroll") for (int k = 0; k < 2; ++k) dst[m][k] = *(const LAS bf16x8*)(lds + PG8_SA(b, h) + aoff + m * 2048 + k * 1024); } while (0)
#define PG8_LDB(dst, b, h) do { _Pragma("unroll") for (int n = 0; n < 2; ++n) _Pragma("unroll") for (int k = 0; k < 2; ++k) dst[n][k] = *(const LAS bf16x8*)(lds + PG8_SB(b, h) + boff + n * 2048 + k * 1024); } while (0)
#define PG8_MMA(ai, bj, At, Bt) do { __builtin_amdgcn_s_setprio(1); _Pragma("unroll") for (int m = 0; m < 4; ++m) _Pragma("unroll") for (int n = 0; n < 2; ++n) _Pragma("unroll") for (int k = 0; k < 2; ++k) \
        acc[ai][bj][m][n] = __builtin_amdgcn_mfma_f32_16x16x32_bf16(Bt[n][k], At[m][k], acc[ai][bj][m][n], 0, 0, 0); __builtin_amdgcn_s_setprio(0); } while (0)
#define PG8_WAIT_V(n) asm volatile("s_waitcnt vmcnt(" #n ")" ::: "memory")
#define PG8_WAIT_L(n) asm volatile("s_waitcnt lgkmcnt(" #n ")" ::: "memory")
#define PG8_BAR __builtin_amdgcn_s_barrier()
#define PG8_SCHED __builtin_amdgcn_sched_barrier(0)
    Unit cur, nxt; int ui = 0;
    if (!S.next(0, cur)) return;
    f32x4 acc[2][2][4][2];
#pragma unroll
    for (int a = 0; a < 2; ++a)
#pragma unroll
        for (int b = 0; b < 2; ++b)
#pragma unroll
            for (int m = 0; m < 4; ++m)
#pragma unroll
                for (int n = 0; n < 2; ++n) acc[a][b][m][n] = (f32x4){0.f, 0.f, 0.f, 0.f};
    bf16x8 At[4][2], B0[2][2], B1[2][2];
    const char* cA = (const char*)g.A + (size_t)cur.pm * tstep; const char* cB = (const char*)g.Bt + (size_t)cur.pn * tstep;
    S.a_ready(cur);
    PG8_STAGE(PG8_SB(0, 0), cB, voffB); PG8_STAGE(PG8_SB(0, 1), cB + hstep, voffB); PG8_STAGE(PG8_SA(0, 0), cA, voffA); PG8_STAGE(PG8_SA(0, 1), cA + hstep, voffA);
    if (wr == 1) PG8_BAR;
    PG8_WAIT_V(2); PG8_BAR;
    PG8_STAGE(PG8_SB(1, 0), cB + kstep, voffB); PG8_STAGE(PG8_SA(1, 0), cA + kstep, voffA); PG8_STAGE(PG8_SB(1, 1), cB + hstep + kstep, voffB);
    PG8_WAIT_V(6); PG8_BAR;
    for (;;) {
        const bool has_next = S.next(ui + 1, nxt);
        const char* nA = has_next ? (const char*)g.A + (size_t)nxt.pm * tstep : cA; const char* nB = has_next ? (const char*)g.Bt + (size_t)nxt.pn * tstep : cB;
        for (int t = 0; t < nt; t += 2) {
            const bool last = (t == nt - 2);
            const char* a1 = cA + (size_t)(t + 1) * kstep;
            const char* a2 = last ? nA : cA + (size_t)(t + 2) * kstep; const char* b2 = last ? nB : cB + (size_t)(t + 2) * kstep;
            const char* a3 = a2 + kstep; const char* b3 = b2 + kstep;
            if (last && has_next) S.a_ready(nxt);
            PG8_LDB(B0, 0, 0); PG8_LDB(B1, 0, 1); PG8_SCHED; PG8_LDA(At, 0, 0); PG8_STAGE(PG8_SA(1, 1), a1 + hstep, voffA);
            PG8_WAIT_V(8); PG8_WAIT_L(0); PG8_BAR; PG8_MMA(0, 0, At, B0); PG8_MMA(0, 1, At, B1); PG8_BAR; PG8_SCHED;
            PG8_LDA(At, 0, 1); PG8_STAGE(PG8_SB(0, 0), b2, voffB); PG8_STAGE(PG8_SB(0, 1), b2 + hstep, voffB); PG8_STAGE(PG8_SA(0, 0), a2, voffA);
            PG8_WAIT_V(8); PG8_WAIT_L(0); PG8_BAR; PG8_MMA(1, 0, At, B0); PG8_MMA(1, 1, At, B1); PG8_BAR; PG8_SCHED;
            PG8_LDB(B0, 1, 0); PG8_LDB(B1, 1, 1); PG8_SCHED; PG8_LDA(At, 1, 0); PG8_STAGE(PG8_SA(0, 1), a2 + hstep, voffA);
            PG8_WAIT_V(8); PG8_WAIT_L(0); PG8_BAR; PG8_MMA(0, 0, At, B0); PG8_MMA(0, 1, At, B1); PG8_BAR; PG8_SCHED;
            PG8_LDA(At, 1, 1); PG8_STAGE(PG8_SB(1, 0), b3, voffB); PG8_STAGE(PG8_SB(1, 1), b3 + hstep, voffB); PG8_STAGE(PG8_SA(1, 0), a3, voffA);
            PG8_WAIT_V(8); PG8_WAIT_L(0); PG8_BAR; PG8_MMA(1, 0, At, B0); PG8_MMA(1, 1, At, B1); PG8_BAR; PG8_SCHED;
        }
        if (wr == 0) PG8_BAR;
        E(acc, cur, wr, wc, fr, fq); S.done(cur);
        if (!has_next) break;
#pragma unroll
        for (int a = 0; a < 2; ++a)
#pragma unroll
            for (int b = 0; b < 2; ++b)
#pragma unroll
                for (int m = 0; m < 4; ++m)
#pragma unroll
                    for (int n = 0; n < 2; ++n) acc[a][b][m][n] = (f32x4){0.f, 0.f, 0.f, 0.f};
        cur = nxt; cA = nA; cB = nB; ++ui;
        if (wr == 1) PG8_BAR;
    }
    PG8_WAIT_V(0);
    PG8_BAR;
#undef PG8_SA
#undef PG8_SB
#undef PG8_STAGE
#undef PG8_LDA
#undef PG8_LDB
#undef PG8_MMA
#undef PG8_WAIT_V
#undef PG8_WAIT_L
#undef PG8_BAR
#undef PG8_SCHED
}
}

namespace att {
constexpr int D = 128, NW = 8, QBLK = 32, KVBLK = 64;
constexpr float THR = 8.f;
constexpr int LDQ = QKV_N, LDK = QKV_N, LDO = DM;
constexpr int NBUF = 3, BUF_V = KVBLK * D * 2, BUF_BYTES = 3 * BUF_V;
constexpr int OFF_WS = NBUF * BUF_BYTES, OFF_TAB = OFF_WS + NW * 64 * 4, ATT_LDS = OFF_TAB + 2048;
#define KSWZ(row, colB) ((row) * 256 + ((colB) ^ (((row) & 15) << 4)))
#define SBAR() __builtin_amdgcn_sched_barrier(0)
__device__ __forceinline__ int crow(int r, int hi) { return (r & 3) + 8 * (r >> 2) + 4 * hi; }

__device__ __forceinline__ void partialSM(f32x16& p0, f32x16& p1, float& m_reg, float& mn, float& alpha) {
  constexpr float C = LOG2E;
  float pmax = p0[0];
#pragma unroll
  for (int r = 1; r < 16; ++r) pmax = fmaxf(pmax, p0[r]);
#pragma unroll
  for (int r = 0; r < 16; ++r) pmax = fmaxf(pmax, p1[r]);
  { auto rr = __builtin_amdgcn_permlane32_swap(__float_as_uint(pmax), __float_as_uint(pmax), false, false);
    pmax = fmaxf(__uint_as_float(rr[0]), __uint_as_float(rr[1])); }
  if (__builtin_expect(__all(pmax - m_reg <= THR), 1)) { mn = m_reg; alpha = 1.f; }
  else { mn = fmaxf(m_reg, pmax); alpha = __builtin_amdgcn_exp2f((m_reg - mn) * C); m_reg = mn; }
  float mnC = -mn * C;
#pragma unroll
  for (int r = 0; r < 16; ++r) p0[r] = fmaf(p0[r], C, mnC);
#pragma unroll
  for (int r = 0; r < 16; ++r) p1[r] = fmaf(p1[r], C, mnC);
#pragma unroll
  for (int r = 0; r < 16; ++r) p0[r] = __builtin_amdgcn_exp2f(p0[r]);
}
__device__ __forceinline__ void finishSM(f32x16& p0, f32x16& p1, float alpha, float& l_reg, bf16x8& pa0, bf16x8& pa1, bf16x8& pa2, bf16x8& pa3) {
#pragma unroll
  for (int r = 0; r < 16; ++r) p1[r] = __builtin_amdgcn_exp2f(p1[r]);
  float ps = 0;
#pragma unroll
  for (int r = 0; r < 16; ++r) ps += p0[r];
#pragma unroll
  for (int r = 0; r < 16; ++r) ps += p1[r];
  { auto rr = __builtin_amdgcn_permlane32_swap(__float_as_uint(ps), __float_as_uint(ps), false, false);
    ps = __uint_as_float(rr[0]) + __uint_as_float(rr[1]); }
  l_reg = l_reg * alpha + ps;
#define PK4(P, BASE, OUT) do { unsigned a0 = cvt_pk_bf16(P[BASE + 0], P[BASE + 1]), a1 = cvt_pk_bf16(P[BASE + 2], P[BASE + 3]);   \
    unsigned b0 = cvt_pk_bf16(P[BASE + 4], P[BASE + 5]), b1 = cvt_pk_bf16(P[BASE + 6], P[BASE + 7]);                              \
    auto r0 = __builtin_amdgcn_permlane32_swap(a0, b0, false, false); auto r1 = __builtin_amdgcn_permlane32_swap(a1, b1, false, false); \
    u32x4 w = {r0[0], r1[0], r0[1], r1[1]}; OUT = *reinterpret_cast<bf16x8*>(&w); } while (0)
  PK4(p0, 0, pa0); PK4(p0, 8, pa1); PK4(p1, 0, pa2); PK4(p1, 8, pa3);
#undef PK4
}
__device__ __forceinline__ void qkt(f32x16& p0, f32x16& p1, const char* Ks, const bf16x8* qr, int r32, int hi, const LAS float* tab, int rel0, int farmode) {
  if (farmode != 0) { const float c = tab[farmode < 0 ? 0 : 384];
#pragma unroll
    for (int r = 0; r < 16; ++r) { p0[r] = c; p1[r] = c; }
  } else {
    const LAS float* tb = tab + (rel0 + 192 + 4 * hi);
#pragma unroll
    for (int r = 0; r < 16; ++r) { p0[r] = tb[(r & 3) + 8 * (r >> 2)]; p1[r] = tb[32 + (r & 3) + 8 * (r >> 2)]; }
  }
#pragma unroll
  for (int d0 = 0; d0 < 8; ++d0) { int cb = (d0 * 16 + hi * 8) * 2;
    bf16x8 b0 = *reinterpret_cast<const bf16x8*>(Ks + KSWZ(r32, cb));
    bf16x8 b1 = *reinterpret_cast<const bf16x8*>(Ks + KSWZ(32 + r32, cb));
    p0 = __builtin_amdgcn_mfma_f32_32x32x16_bf16(b0, qr[d0], p0, 0, 0, 0);
    p1 = __builtin_amdgcn_mfma_f32_32x32x16_bf16(b1, qr[d0], p1, 0, 0, 0); }
}
__device__ __forceinline__ int v_st(int k, int c) { const int kk = (k & ~0xC) | ((k & 4) << 1) | ((k & 8) >> 1); return ((kk >> 3) * 4 + (c >> 5)) * 512 + ((kk & 7) * 32 + (c & 31)) * 2; }
__device__ __forceinline__ int v_rd_base(int lane) { return ((lane & 3) << 3) | (((lane >> 2) & 3) << 6) | (((lane >> 4) & 1) << 5) | (((lane >> 5) & 1) << 8); }
constexpr int v_rd_off(int d0, int ks, int half) { return d0 * 512 + ks * 4096 + half * 2048; }
template <int OFF> __device__ __forceinline__ s16x4 tr_read(int vb) {
  s16x4 r; asm volatile("ds_read_b64_tr_b16 %0, %1 offset:%2" : "=&v"(r) : "v"(vb), "i"(OFF) : "memory"); return r;
}
template <int D0> __device__ __forceinline__ void pv_one(f32x16& od, int vb, bf16x8 pa0, bf16x8 pa1, bf16x8 pa2, bf16x8 pa3) {
  const s16x4 l0 = tr_read<v_rd_off(D0, 0, 0)>(vb), h0 = tr_read<v_rd_off(D0, 0, 1)>(vb), l1 = tr_read<v_rd_off(D0, 1, 0)>(vb), h1 = tr_read<v_rd_off(D0, 1, 1)>(vb);
  const s16x4 l2 = tr_read<v_rd_off(D0, 2, 0)>(vb), h2 = tr_read<v_rd_off(D0, 2, 1)>(vb), l3 = tr_read<v_rd_off(D0, 3, 0)>(vb), h3 = tr_read<v_rd_off(D0, 3, 1)>(vb);
  asm volatile("s_waitcnt lgkmcnt(0)" ::: "memory"); SBAR();
#define PK(L, H) (bf16x8){L[0], L[1], L[2], L[3], H[0], H[1], H[2], H[3]}
  od = __builtin_amdgcn_mfma_f32_32x32x16_bf16(pa0, PK(l0, h0), od, 0, 0, 0);
  od = __builtin_amdgcn_mfma_f32_32x32x16_bf16(pa1, PK(l1, h1), od, 0, 0, 0);
  od = __builtin_amdgcn_mfma_f32_32x32x16_bf16(pa2, PK(l2, h2), od, 0, 0, 0);
  od = __builtin_amdgcn_mfma_f32_32x32x16_bf16(pa3, PK(l3, h3), od, 0, 0, 0);
#undef PK
}
__device__ __forceinline__ void pv_d0(f32x16* o, int vb, bf16x8 pa0, bf16x8 pa1, bf16x8 pa2, bf16x8 pa3) {
  pv_one<0>(o[0], vb, pa0, pa1, pa2, pa3); pv_one<1>(o[1], vb, pa0, pa1, pa2, pa3); pv_one<2>(o[2], vb, pa0, pa1, pa2, pa3); pv_one<3>(o[3], vb, pa0, pa1, pa2, pa3);
}
constexpr int v_off8(int d, int ks, int half) { return (d >> 2) * BUF_V + (d & 3) * 512 + ks * 4096 + half * 2048; }
#define PV_LOAD(S, DD) do { S[0] = tr_read<v_off8(DD, 0, 0)>(vb); S[1] = tr_read<v_off8(DD, 0, 1)>(vb); S[2] = tr_read<v_off8(DD, 1, 0)>(vb); S[3] = tr_read<v_off8(DD, 1, 1)>(vb); \
    S[4] = tr_read<v_off8(DD, 2, 0)>(vb); S[5] = tr_read<v_off8(DD, 2, 1)>(vb); S[6] = tr_read<v_off8(DD, 3, 0)>(vb); S[7] = tr_read<v_off8(DD, 3, 1)>(vb); } while (0)
#define PV_PK(L, H) (bf16x8){L[0], L[1], L[2], L[3], H[0], H[1], H[2], H[3]}
#define PV_MMA(OD, S) do { OD = __builtin_amdgcn_mfma_f32_32x32x16_bf16(pa0, PV_PK(S[0], S[1]), OD, 0, 0, 0); OD = __builtin_amdgcn_mfma_f32_32x32x16_bf16(pa1, PV_PK(S[2], S[3]), OD, 0, 0, 0); \
    OD = __builtin_amdgcn_mfma_f32_32x32x16_bf16(pa2, PV_PK(S[4], S[5]), OD, 0, 0, 0); OD = __builtin_amdgcn_mfma_f32_32x32x16_bf16(pa3, PV_PK(S[6], S[7]), OD, 0, 0, 0); } while (0)
#define PV_W8() do { asm volatile("s_waitcnt lgkmcnt(8)" ::: "memory"); SBAR(); } while (0)
#define PV_W0() do { asm volatile("s_waitcnt lgkmcnt(0)" ::: "memory"); SBAR(); } while (0)
__device__ __forceinline__ void pv8(f32x16* o, int vb, bf16x8 pa0, bf16x8 pa1, bf16x8 pa2, bf16x8 pa3) {
  s16x4 A[8], B[8];
  PV_LOAD(A, 0);
  PV_LOAD(B, 1); PV_W8(); PV_MMA(o[0], A); SBAR();
  PV_LOAD(A, 2); PV_W8(); PV_MMA(o[1], B); SBAR();
  PV_LOAD(B, 3); PV_W8(); PV_MMA(o[2], A); SBAR();
  PV_LOAD(A, 4); PV_W8(); PV_MMA(o[3], B); SBAR();
  PV_LOAD(B, 5); PV_W8(); PV_MMA(o[4], A); SBAR();
  PV_LOAD(A, 6); PV_W8(); PV_MMA(o[5], B); SBAR();
  PV_LOAD(B, 7); PV_W8(); PV_MMA(o[6], A); SBAR();
  PV_W0(); PV_MMA(o[7], B);
}

__device__ __forceinline__ void attn_pass(const bf16_t* __restrict__ Qb, const bf16_t* __restrict__ Kh, const bf16_t* __restrict__ Vh,
                                          float* Ob, int mode, float lam, int qpos0, int seq, char* lds, const int wv) {
  const int tid = otid(wv), wid = __builtin_amdgcn_readfirstlane(tid >> 6), lane = tid & 63, r32 = lane & 31, hi = lane >> 5;
  float* ws = (float*)(lds + OFF_WS) + wid * 64; float* li_l = ws; float* al_l = ws + 32;
  const LAS float* tab = (const LAS float*)(LAS char*)(lds + OFF_TAB);
  float m_reg = -1e30f, l_reg = 0; f32x16 o[8] = {}; bf16x8 qr[8];
  const bf16_t* Qw = Qb + (long)(wid * QBLK + r32) * LDQ + hi * 8;
#pragma unroll
  for (int d0 = 0; d0 < 8; ++d0) qr[d0] = *reinterpret_cast<const bf16x8*>(Qw + d0 * 16);
  const int vb0 = (int)(uintptr_t)(LAS char*)lds + BUF_V + v_rd_base(lane);
  const int qw0 = qpos0 + wid * QBLK, qlane = qw0 + r32;
  unsigned koff[2], voff[2];
#pragma unroll
  for (int i = 0; i < 2; ++i) { const int p = i * 512 + wid * 64 + lane;
    { const int row = p >> 4, g = p & 15; koff[i] = (unsigned)(row * LDK * 2 + ((g ^ (row & 15)) << 4)); }
    { const int kk = ((p >> 7) << 3) | ((p >> 2) & 7), c = ((p >> 5) & 3) * 32 + (p & 3) * 8; const int k = (kk & ~0xC) | ((kk & 4) << 1) | ((kk & 8) >> 1); voff[i] = (unsigned)(k * LDK * 2 + c * 2); } }
  LAS unsigned char* ldsw = (LAS unsigned char*)lds + wid * 1024;
#define DMA(tile, boff) do { const char* kg_ = (const char*)Kh + (size_t)(tile) * (KVBLK * LDK * 2); const char* vg_ = (const char*)Vh + (size_t)(tile) * (KVBLK * LDK * 2); \
    __builtin_amdgcn_global_load_lds((const unsigned*)(kg_ + koff[0]), (LAS unsigned*)(ldsw + (boff)), 16, 0, 0);                  \
    __builtin_amdgcn_global_load_lds((const unsigned*)(kg_ + koff[1]), (LAS unsigned*)(ldsw + (boff) + 8192), 16, 0, 0);           \
    __builtin_amdgcn_global_load_lds((const unsigned*)(vg_ + voff[0]), (LAS unsigned*)(ldsw + (boff) + BUF_V), 16, 0, 0);          \
    __builtin_amdgcn_global_load_lds((const unsigned*)(vg_ + voff[1]), (LAS unsigned*)(ldsw + (boff) + BUF_V + 8192), 16, 0, 0);   \
    __builtin_amdgcn_global_load_lds((const unsigned*)(vg_ + 256 + voff[0]), (LAS unsigned*)(ldsw + (boff) + 2 * BUF_V), 16, 0, 0);        \
    __builtin_amdgcn_global_load_lds((const unsigned*)(vg_ + 256 + voff[1]), (LAS unsigned*)(ldsw + (boff) + 2 * BUF_V + 8192), 16, 0, 0); } while (0)
#define STEP_SYNC() do { asm volatile("s_waitcnt vmcnt(0) lgkmcnt(0)" ::: "memory"); __builtin_amdgcn_s_barrier(); asm volatile("" ::: "memory"); } while (0)
#define RESC(a) do { if (__any((a) < 1.f)) { if (hi == 0) al_l[r32] = (a); asm volatile("s_waitcnt lgkmcnt(0)" ::: "memory"); \
    _Pragma("unroll") for (int d = 0; d < 8; ++d) _Pragma("unroll") for (int r = 0; r < 16; ++r) o[d][r] *= al_l[crow(r, hi)]; } } while (0)
#define FARMODE(k0) (((k0) + 63 - qw0 <= -91) ? -1 : (((k0) - (qw0 + 31) >= 91) ? 1 : 0))
  f32x16 p0, p1; float mn, al; bf16x8 pa0, pa1, pa2, pa3; const int NT = seq / KVBLK;
  int bprev = 0, bcur = 0, bnext = BUF_BYTES;
#define ROT() do { bprev = bcur; bcur = bnext; bnext = (bnext + BUF_BYTES == NBUF * BUF_BYTES) ? 0 : bnext + BUF_BYTES; } while (0)
  DMA(0, 0); STEP_SYNC();
  if (wid < 4) {
#pragma unroll 1
    for (int j = 0; j < NT; ++j) {
      if (j + 1 < NT) DMA(j + 1, bnext);
      SBAR();
      __builtin_amdgcn_s_setprio(1);
      { const int k0 = j * KVBLK; qkt(p0, p1, lds + bcur, qr, r32, hi, tab, k0 - qlane, FARMODE(k0)); }
      __builtin_amdgcn_s_setprio(0);
      partialSM(p0, p1, m_reg, mn, al);
      RESC(al);
      finishSM(p0, p1, al, l_reg, pa0, pa1, pa2, pa3); SBAR();
      __builtin_amdgcn_s_setprio(1);
      pv8(o, vb0 + bcur, pa0, pa1, pa2, pa3);
      __builtin_amdgcn_s_setprio(0);
      STEP_SYNC();
      ROT();
    }
  } else {
    DMA(1, bnext);
    SBAR();
    qkt(p0, p1, lds + bcur, qr, r32, hi, tab, 0 - qlane, FARMODE(0));
    partialSM(p0, p1, m_reg, mn, al);
    finishSM(p0, p1, al, l_reg, pa0, pa1, pa2, pa3); SBAR();
    STEP_SYNC();
    ROT();
#pragma unroll 1
    for (int j = 1; j < NT; ++j) {
      if (j + 1 < NT) DMA(j + 1, bnext);
      SBAR();
      __builtin_amdgcn_s_setprio(1);
      pv8(o, vb0 + bprev, pa0, pa1, pa2, pa3);
      SBAR();
      { const int k0 = j * KVBLK; qkt(p0, p1, lds + bcur, qr, r32, hi, tab, k0 - qlane, FARMODE(k0)); }
      __builtin_amdgcn_s_setprio(0);
      partialSM(p0, p1, m_reg, mn, al);
      RESC(al);
      finishSM(p0, p1, al, l_reg, pa0, pa1, pa2, pa3); SBAR();
      STEP_SYNC();
      ROT();
    }
    pv8(o, vb0 + bprev, pa0, pa1, pa2, pa3);
  }
#undef ROT
  if (hi == 0) li_l[r32] = l_reg; asm volatile("s_waitcnt lgkmcnt(0)" ::: "memory");
  float rli[16];
#pragma unroll
  for (int r = 0; r < 16; ++r) rli[r] = __builtin_amdgcn_rcpf(li_l[crow(r, hi)]);
  __syncthreads();
  float* stg = (float*)(lds + wid * 16384);
  float* Ow = Ob + (long)(wid * QBLK) * LDO;
  const int srow = lane >> 5, sc4 = (lane & 31) * 4;
#pragma unroll
  for (int half = 0; half < 2; ++half) {
#pragma unroll
    for (int d = 0; d < 4; ++d)
#pragma unroll
      for (int r = 0; r < 16; ++r) stg[crow(r, hi) * 128 + d * 32 + r32] = o[half * 4 + d][r] * rli[r];
    asm volatile("s_waitcnt lgkmcnt(0)" ::: "memory");
    if (mode == 0) {
#pragma unroll
      for (int k = 0; k < 16; ++k) { const int row = 2 * k + srow; const f32x4 v = *(const f32x4*)(stg + row * 128 + sc4);
        *(f32x4*)(Ow + (long)row * LDO + half * 128 + sc4) = v; }
    } else {
#pragma unroll
      for (int k = 0; k < 16; ++k) { const int row = 2 * k + srow; const f32x4 v = *(const f32x4*)(stg + row * 128 + sc4);
        f32x4* gp = (f32x4*)(Ow + (long)row * LDO + half * 128 + sc4); *gp = *gp - lam * v; }
    }
    asm volatile("s_waitcnt lgkmcnt(0)" ::: "memory");
  }
#undef DMA
#undef STEP_SYNC
#undef RESC
#undef FARMODE
}
}

struct Args { const float* in[19]; float* out; unsigned char* ws; int lo, hi, coop, pad; };
typedef const __attribute__((address_space(4))) Args* KArgs;
__device__ __forceinline__ KArgs kargs() { auto p = __builtin_amdgcn_kernarg_segment_ptr(); asm volatile("" : "+s"(p)); return (KArgs)p; }

struct TItem { const float* W; bf16_t* WT; int K, N, k0, n0, drow0; };
__device__ __forceinline__ void tile_load(const TItem& t, f32x4 (&v)[8], int lane) {
#pragma unroll
    for (int i = 0; i < 8; ++i) { const int kk = 8 * i + (lane >> 3); v[i] = *(const f32x4*)(t.W + (size_t)(t.k0 + kk) * t.N + t.n0 + 4 * (lane & 7)); }
}
__device__ __forceinline__ void tile_store(const TItem& t, const f32x4 (&v)[8], LAS float* scr, int lane) {
#pragma unroll
    for (int i = 0; i < 8; ++i) { const int kk = 8 * i + (lane >> 3); LAS float* s = scr + kk * 33 + 4 * (lane & 7); s[0] = v[i][0]; s[1] = v[i][1]; s[2] = v[i][2]; s[3] = v[i][3]; }
    asm volatile("s_waitcnt lgkmcnt(0)" ::: "memory");
    const int c = lane & 7;
#pragma unroll
    for (int j = 0; j < 4; ++j) { const int n = (lane >> 3) + 8 * j; const LAS float* s = scr + (8 * c) * 33 + n;
        u32x4 o; o.x = cvt_pk_bf16(s[0 * 33], s[1 * 33]); o.y = cvt_pk_bf16(s[2 * 33], s[3 * 33]); o.z = cvt_pk_bf16(s[4 * 33], s[5 * 33]); o.w = cvt_pk_bf16(s[6 * 33], s[7 * 33]);
        *(u32x4*)(t.WT + (size_t)(t.drow0 + n) * t.K + t.k0 + 8 * c) = o; }
    asm volatile("s_waitcnt lgkmcnt(0)" ::: "memory");
}

template <int NR> __device__ __forceinline__ void norm_phase_t(const bf16_t* mbuf, const float* ga, const float* xin, float* xout, const float* gb, bf16_t* hout, int gw, int NGW, int lane) {
    for (int row = gw; row < M_TOK; row += NR * NGW) {
        f32x4 xv[NR][8]; u32x4 mv[NR][4];
#pragma unroll
        for (int rr = 0; rr < NR; ++rr) { const int r = row + rr * NGW; if (r < M_TOK) {
            const float* xr = xin + (size_t)r * DM + 8 * lane;
#pragma unroll
            for (int j = 0; j < 4; ++j) { xv[rr][2 * j] = __builtin_nontemporal_load((const f32x4*)(xr + 512 * j)); xv[rr][2 * j + 1] = __builtin_nontemporal_load((const f32x4*)(xr + 512 * j + 4)); }
            if (mbuf) {
#pragma unroll
                for (int j = 0; j < 4; ++j) mv[rr][j] = __builtin_nontemporal_load((const u32x4*)(mbuf + (size_t)r * DM + 8 * lane + 512 * j)); } } }
#pragma unroll
        for (int rr = 0; rr < NR; ++rr) { const int r = row + rr * NGW; if (r < M_TOK) {
            if (mbuf) {
                float ss = 0.f;
#pragma unroll
                for (int j = 0; j < 4; ++j)
#pragma unroll
                    for (int k = 0; k < 4; ++k) { const float lo = bf_lo(mv[rr][j][k]), hi = bf_hi(mv[rr][j][k]); ss += lo * lo + hi * hi; }
                const float rs = 1.0f / sqrtf(wave_sum(ss) * (1.0f / DM) + EPS);
                float* xo = xout + (size_t)r * DM + 8 * lane;
#pragma unroll
                for (int j = 0; j < 4; ++j) { const f32x4 g0 = *(const f32x4*)(ga + 8 * lane + 512 * j), g1 = *(const f32x4*)(ga + 8 * lane + 512 * j + 4);
                    const f32x4 m0 = {bf_lo(mv[rr][j][0]), bf_hi(mv[rr][j][0]), bf_lo(mv[rr][j][1]), bf_hi(mv[rr][j][1])}, m1 = {bf_lo(mv[rr][j][2]), bf_hi(mv[rr][j][2]), bf_lo(mv[rr][j][3]), bf_hi(mv[rr][j][3])};
                    xv[rr][2 * j] = xv[rr][2 * j] + m0 * rs * g0; xv[rr][2 * j + 1] = xv[rr][2 * j + 1] + m1 * rs * g1;
                    __builtin_nontemporal_store(xv[rr][2 * j], (f32x4*)(xo + 512 * j)); __builtin_nontemporal_store(xv[rr][2 * j + 1], (f32x4*)(xo + 512 * j + 4)); }
            }
            if (hout) {
                float ss = 0.f;
#pragma unroll
                for (int j = 0; j < 8; ++j) ss += (xv[rr][j][0] * xv[rr][j][0] + xv[rr][j][1] * xv[rr][j][1]) + (xv[rr][j][2] * xv[rr][j][2] + xv[rr][j][3] * xv[rr][j][3]);
                const float rs = 1.0f / sqrtf(wave_sum(ss) * (1.0f / DM) + EPS);
                bf16_t* ho = hout + (size_t)r * DM + 8 * lane;
#pragma unroll
                for (int j = 0; j < 4; ++j) { const f32x4 g0 = *(const f32x4*)(gb + 8 * lane + 512 * j), g1 = *(const f32x4*)(gb + 8 * lane + 512 * j + 4);
                    const f32x4 y0 = xv[rr][2 * j] * rs * g0, y1 = xv[rr][2 * j + 1] * rs * g1;
                    u32x4 w; w.x = cvt_pk_bf16(y0[0], y0[1]); w.y = cvt_pk_bf16(y0[2], y0[3]); w.z = cvt_pk_bf16(y1[0], y1[1]); w.w = cvt_pk_bf16(y1[2], y1[3]);
                    *(u32x4*)(ho + 512 * j) = w; }
            } } }
    }
}

__device__ __forceinline__ void norm_phase(const bf16_t* mbuf, const float* ga, const float* xin, float* xout, const float* gb, bf16_t* hout, int gw, int NGW, int lane) {
    norm_phase_t<4>(mbuf, ga, xin, xout, gb, hout, gw, NGW, lane);
}
__device__ __forceinline__ TItem prep_decode(int it) {
    KArgs ap = kargs(); unsigned char* ws = ap->ws;
    constexpr int I_IN = 32 * 128, I_OAB = 32 * 64, I_QKV = 32 * 192, I_OC = 32 * 64, I_G = 32 * 176, I_D = 88 * 64;
    int r = it; TItem t; int mode;
    if (r < 2 * I_IN) { const int e = r / I_IN; r -= e * I_IN; t.W = ap->in[2] + (size_t)e * DM * IN_AB; t.WT = (bf16_t*)(ws + WS_WIN + e * SZ_WIN); t.K = DM; t.N = IN_AB; mode = 1; }
    else { r -= 2 * I_IN;
    if (r < 2 * I_OAB) { const int e = r / I_OAB; r -= e * I_OAB; t.W = ap->in[10] + (size_t)e * DM * DM; t.WT = (bf16_t*)(ws + WS_WOAB + e * SZ_WOAB); t.K = DM; t.N = DM; mode = 0; }
    else { r -= 2 * I_OAB;
    if (r < 2 * I_QKV) { const int e = r / I_QKV; r -= e * I_QKV; t.W = ap->in[11] + (size_t)e * DM * QKV_N; t.WT = (bf16_t*)(ws + WS_WQKV + e * SZ_WQKV); t.K = DM; t.N = QKV_N; mode = 0; }
    else { r -= 2 * I_QKV;
    if (r < 2 * I_OC) { const int e = r / I_OC; r -= e * I_OC; t.W = ap->in[14] + (size_t)e * DM * DM; t.WT = (bf16_t*)(ws + WS_WOC + e * SZ_WOC); t.K = DM; t.N = DM; mode = 0; }
    else { r -= 2 * I_OC;
        const int per = 2 * I_G + I_D; const int l = r / per; r -= l * per;
        if (r < I_G) { t.W = ap->in[16] + (size_t)l * DM * DFF; t.WT = (bf16_t*)(ws + WS_WGU + l * SZ_WGU); t.K = DM; t.N = DFF; mode = 2; }
        else if (r < 2 * I_G) { r -= I_G; t.W = ap->in[17] + (size_t)l * DM * DFF; t.WT = (bf16_t*)(ws + WS_WGU + l * SZ_WGU); t.K = DM; t.N = DFF; mode = 3; }
        else { r -= 2 * I_G; t.W = ap->in[18] + (size_t)l * DFF * DM; t.WT = (bf16_t*)(ws + WS_WDN + l * SZ_WDN); t.K = DFF; t.N = DM; mode = 0; }
    } } } }
    const int nblk = t.N / 32, kb = r / nblk, nb = r % nblk; t.k0 = 64 * kb; t.n0 = 32 * nb;
    const int n0 = t.n0; int drow0 = n0;
    if (mode == 1) { if (n0 < 1024) drow0 = (n0 >> 7) * 256 + (n0 & 127); else if (n0 < 2048) { const int ch = n0 - 1024; drow0 = (ch >> 7) * 256 + 128 + (ch & 127); } }
    else if (mode == 2) drow0 = (n0 >> 7) * 256 + (n0 & 127);
    else if (mode == 3) drow0 = (n0 >> 7) * 256 + 128 + (n0 & 127);
    t.drow0 = drow0; return t;
}
__device__ __forceinline__ void prep_phase(unsigned char* lds, int vcu, int G, const int wv) {
    KArgs ap = kargs();
    const int tid = otid(wv), wid = __builtin_amdgcn_readfirstlane(tid >> 6), lane = tid & 63;
    LAS float* scr = (LAS float*)(LAS unsigned char*)lds + wid * (64 * 33);
    const int gw = vcu * 8 + wid, NGW = G * 8;
    constexpr int I_IN = 32 * 128, I_OAB = 32 * 64, I_QKV = 32 * 192, I_OC = 32 * 64, I_G = 32 * 176, I_D = 88 * 64;
    constexpr int NITEMS = 2 * I_IN + 2 * I_OAB + 2 * I_QKV + 2 * I_OC + 4 * (2 * I_G + I_D);
    unsigned char* ws = ap->ws;
    int it = gw;
    if (it < NITEMS) {
        TItem cur = prep_decode(it); f32x4 v[8]; tile_load(cur, v, lane);
        for (;;) {
            const int nit = it + NGW; const bool has = nit < NITEMS; TItem nx = cur; f32x4 vn[8];
            if (has) { nx = prep_decode(nit); tile_load(nx, vn, lane); }
            tile_store(cur, v, scr, lane);
            if (!has) break;
            cur = nx; it = nit;
#pragma unroll
            for (int i = 0; i < 8; ++i) v[i] = vn[i];
        }
    }
    norm_phase(nullptr, nullptr, ap->in[0], nullptr, ap->in[1], (bf16_t*)(ws + WS_H), gw, NGW, lane);
}

__device__ __forceinline__ void conv_item(int it, const bf16_t* AG, const float* dw, const float* cg_, const float* cb_, bf16_t* CAT, unsigned char* lds, const int wv) {
    const int tid = otid(wv), wid = __builtin_amdgcn_readfirstlane(tid >> 6), lane = tid & 63;
    const int t0 = it * 32, b = t0 >> 12, s0 = t0 & 4095;
    LAS unsigned char* X = (LAS unsigned char*)lds;
    LAS f32x2* red = (LAS f32x2*)(X + 62 * 2048);
    LAS f32x2* stat = red + 256;
    f32x2 wt[CONV_W];
#pragma unroll
    for (int j = 0; j < CONV_W; ++j) wt[j] = *(const f32x2*)(dw + j * 1024 + 2 * tid);
    __syncthreads();
#pragma unroll
    for (int p = 0; p < 16; ++p) { const int r = p * 4 + (tid >> 7);
        if (r < 62) { const int sp = s0 - 15 + r; u32x4 val = {0u, 0u, 0u, 0u};
            if (sp >= 0 && sp < SEQ) val = *(const u32x4*)(AG + ((size_t)(b * SEQ + sp)) * 1024 + 8 * (tid & 127));
            *(LAS u32x4*)(X + r * 2048 + 16 * (tid & 127)) = val; } }
    __syncthreads();
    f32x2 accv[32];
#pragma unroll
    for (int tt = 0; tt < 32; ++tt) accv[tt] = (f32x2){0.f, 0.f};
    const LAS unsigned* X32 = (const LAS unsigned*)X;
#pragma unroll
    for (int r = 0; r < 62; ++r) {
        const unsigned v = X32[r * 512 + tid]; const f32x2 xf = {bf_lo(v), bf_hi(v)};
#pragma unroll
        for (int tt = (r > 30 ? r - 30 : 0); tt <= (r < 31 ? r : 31); ++tt) accv[tt] = accv[tt] + xf * wt[r - tt];
    }
    float acc[32][2];
#pragma unroll
    for (int tt = 0; tt < 32; ++tt) { acc[tt][0] = accv[tt].x; acc[tt][1] = accv[tt].y; }
#pragma unroll
    for (int tt = 0; tt < 32; ++tt) {
        float s1 = acc[tt][0] + acc[tt][1], s2 = acc[tt][0] * acc[tt][0] + acc[tt][1] * acc[tt][1];
        s1 = wave_sum(s1); s2 = wave_sum(s2);
        if (lane == 0) red[tt * 8 + wid] = (f32x2){s1, s2};
    }
    __syncthreads();
    if (tid < 32) { float s1 = 0.f, s2 = 0.f;
#pragma unroll
        for (int w = 0; w < 8; ++w) { const f32x2 v = red[tid * 8 + w]; s1 += v.x; s2 += v.y; }
        const float mean = s1 * (1.0f / 1024.0f); float var = s2 * (1.0f / 1024.0f) - mean * mean; var = var < 0.f ? 0.f : var;
        stat[tid] = (f32x2){mean, 1.0f / sqrtf(var + EPS)}; }
    __syncthreads();
    const f32x2 g = *(const f32x2*)(cg_ + 2 * tid), bb = *(const f32x2*)(cb_ + 2 * tid);
#pragma unroll
    for (int tt = 0; tt < 32; ++tt) { const f32x2 st = stat[tt];
        float y0 = (acc[tt][0] - st.x) * st.y * g.x + bb.x, y1 = (acc[tt][1] - st.x) * st.y * g.y + bb.y;
        y0 = y0 * sigmoid_f(y0); y1 = y1 * sigmoid_f(y1);
        ((LAS unsigned*)X)[tt * 512 + tid] = cvt_pk_bf16(y0, y1); }
    __syncthreads();
#pragma unroll
    for (int j = 0; j < 8; ++j) { const int c = tid + 512 * j, row = c >> 7, col16 = c & 127;
        const u32x4 v = *(const LAS u32x4*)(X + row * 2048 + col16 * 16);
        *(u32x4*)(CAT + (size_t)(t0 + row) * DM + col16 * 8) = v; }
}

__device__ __forceinline__ void sgu_item(int it, const bf16_t* GV, const bf16_t* ZU, const float* sg_, const float* sb_, const float* wsp, const float* bsp, bf16_t* CAT, unsigned char* lds, const int wv) {
    const int tid = otid(wv), wid = __builtin_amdgcn_readfirstlane(tid >> 6), lane = tid & 63;
    const int chunk = it >> 2, gp = it & 3, tok0 = chunk * 128;
    LAS unsigned char* ZT = (LAS unsigned char*)lds;
    __syncthreads();
    {
        float mean[16], rstd[16];
#pragma unroll
        for (int i = 0; i < 16; ++i) { const bf16_t* row = GV + (size_t)(tok0 + 16 * wid + i) * 1024;
            const u32x4 a = *(const u32x4*)(row + 8 * lane), c = *(const u32x4*)(row + 512 + 8 * lane);
            float v[16];
#pragma unroll
            for (int k = 0; k < 4; ++k) { v[2 * k] = bf_lo(a[k]); v[2 * k + 1] = bf_hi(a[k]); v[8 + 2 * k] = bf_lo(c[k]); v[8 + 2 * k + 1] = bf_hi(c[k]); }
            float s = 0.f;
#pragma unroll
            for (int k = 0; k < 16; ++k) s += v[k];
            const float mu = wave_sum(s) * (1.0f / 1024.0f); float q = 0.f;
#pragma unroll
            for (int k = 0; k < 16; ++k) { const float d = v[k] - mu; q += d * d; }
            mean[i] = mu; rstd[i] = 1.0f / sqrtf(wave_sum(q) * (1.0f / 1024.0f) + EPS); }
#pragma unroll
        for (int gg = 0; gg < 2; ++gg) {
            const int c0 = (2 * gp + gg) * 128 + 2 * lane;
            const f32x2 sgv = *(const f32x2*)(sg_ + c0), sbv = *(const f32x2*)(sb_ + c0);
            float z0[16], z1[16];
#pragma unroll
            for (int i = 0; i < 16; ++i) { const unsigned v = *(const unsigned*)(GV + (size_t)(tok0 + 16 * wid + i) * 1024 + c0);
                z0[i] = (bf_lo(v) - mean[i]) * rstd[i] * sgv.x + sbv.x; z1[i] = (bf_hi(v) - mean[i]) * rstd[i] * sgv.y + sbv.y; }
            u32x4 w0a, w0b, w1a, w1b;
            w0a.x = cvt_pk_bf16(z0[0], z0[1]); w0a.y = cvt_pk_bf16(z0[2], z0[3]); w0a.z = cvt_pk_bf16(z0[4], z0[5]); w0a.w = cvt_pk_bf16(z0[6], z0[7]);
            w0b.x = cvt_pk_bf16(z0[8], z0[9]); w0b.y = cvt_pk_bf16(z0[10], z0[11]); w0b.z = cvt_pk_bf16(z0[12], z0[13]); w0b.w = cvt_pk_bf16(z0[14], z0[15]);
            w1a.x = cvt_pk_bf16(z1[0], z1[1]); w1a.y = cvt_pk_bf16(z1[2], z1[3]); w1a.z = cvt_pk_bf16(z1[4], z1[5]); w1a.w = cvt_pk_bf16(z1[6], z1[7]);
            w1b.x = cvt_pk_bf16(z1[8], z1[9]); w1b.y = cvt_pk_bf16(z1[10], z1[11]); w1b.z = cvt_pk_bf16(z1[12], z1[13]); w1b.w = cvt_pk_bf16(z1[14], z1[15]);
            LAS unsigned char* r0 = ZT + gg * 34816 + (2 * lane) * 272 + 32 * wid;
            *(LAS u32x4*)(r0) = w0a; *(LAS u32x4*)(r0 + 16) = w0b; *(LAS u32x4*)(r0 + 272) = w1a; *(LAS u32x4*)(r0 + 272 + 16) = w1b;
        }
    }
    __syncthreads();
    const int pl = lane & 15, kg = lane >> 4, p = 16 * wid + pl;
#pragma unroll 1
    for (int gg = 0; gg < 2; ++gg) {
        const int g = 2 * gp + gg;
        bf16x8 Y[4];
#pragma unroll
        for (int ks = 0; ks < 4; ++ks) { const float* wp = wsp + ((size_t)g * 128 + p) * 128 + 32 * ks + 8 * kg;
            const f32x4 a = *(const f32x4*)wp, c = *(const f32x4*)(wp + 4);
            u32x4 w; w.x = cvt_pk_bf16(a[0], a[1]); w.y = cvt_pk_bf16(a[2], a[3]); w.z = cvt_pk_bf16(c[0], c[1]); w.w = cvt_pk_bf16(c[2], c[3]);
            Y[ks] = *reinterpret_cast<bf16x8*>(&w); }
        f32x4 acc[8];
#pragma unroll
        for (int ct = 0; ct < 8; ++ct) { acc[ct] = (f32x4){0.f, 0.f, 0.f, 0.f};
#pragma unroll
            for (int ks = 0; ks < 4; ++ks) { const bf16x8 X = *(const LAS bf16x8*)(ZT + gg * 34816 + (16 * ct + pl) * 272 + 64 * ks + 16 * kg);
                acc[ct] = __builtin_amdgcn_mfma_f32_16x16x32_bf16(X, Y[ks], acc[ct], 0, 0, 0); } }
        const float bs = bsp[g * 128 + p]; const size_t tok = (size_t)(tok0 + p);
#pragma unroll
        for (int ct = 0; ct < 8; ++ct) { const int c = g * 128 + 16 * ct + 4 * kg;
            const u32x2 zu = *(const u32x2*)(ZU + tok * 1024 + c);
            const float o0 = bf_lo(zu.x) * (acc[ct][0] + bs), o1 = bf_hi(zu.x) * (acc[ct][1] + bs), o2 = bf_lo(zu.y) * (acc[ct][2] + bs), o3 = bf_hi(zu.y) * (acc[ct][3] + bs);
            u32x2 w; w.x = cvt_pk_bf16(o0, o1); w.y = cvt_pk_bf16(o2, o3);
            *(u32x2*)(CAT + tok * DM + 1024 + c) = w; }
    }
}

__device__ __forceinline__ int t5_bucket(int rel) {
    const int n = rel < 0 ? -rel : rel; int v;
    if (n < 8) v = n; else if (n < 12) v = 8; else if (n < 16) v = 9; else if (n < 23) v = 10; else if (n < 32) v = 11; else if (n < 46) v = 12; else if (n < 64) v = 13; else if (n < 91) v = 14; else v = 15;
    return (rel > 0 ? 16 : 0) + v;
}

__device__ __forceinline__ void attn_item(int it, int layer, const bf16_t* QKV, float* SCR, bf16_t* OB, unsigned char* lds, const int wv) {
    const int tid = otid(wv), wid = __builtin_amdgcn_readfirstlane(tid >> 6), lane = tid & 63;
    const int o = layer >> 1;
    const int b = it >> 7, h = (it >> 4) & 7, qb = it & 15;
    const float lambda_init = 0.8f - 0.6f * expf(-0.3f * (float)layer);
    float lam;
    { const float* lq = kargs()->in[12] + (size_t)o * 4 * 128;
      float d1 = lq[lane] * lq[128 + lane] + lq[64 + lane] * lq[128 + 64 + lane], d2 = lq[256 + lane] * lq[384 + lane] + lq[256 + 64 + lane] * lq[384 + 64 + lane];
      d1 = wave_sum(d1); d2 = wave_sum(d2); lam = expf(d1) - expf(d2) + lambda_init; lam = __uint_as_float(__builtin_amdgcn_readfirstlane(__float_as_uint(lam))); }
    __syncthreads();
    LAS float* tab = (LAS float*)(LAS unsigned char*)(lds + att::OFF_TAB);
    if (tid < 385) tab[tid] = kargs()->in[15][t5_bucket(tid - 192) * 8 + h];
    __syncthreads();
    const size_t row0 = (size_t)b * SEQ + (size_t)qb * 256;
    const bf16_t* Qrow = QKV + row0 * QKV_N + h * 256;
    const bf16_t* Kb = QKV + (size_t)b * SEQ * QKV_N + 2048 + h * 256;
    const bf16_t* Vb = QKV + (size_t)b * SEQ * QKV_N + 4096 + h * 256;
    float* Ob = SCR + row0 * DM + h * 256;
#pragma unroll 1
    for (int c = 0; c < 2; ++c) {
        __syncthreads();
        att::attn_pass(Qrow + c * 128, Kb + c * 128, Vb, Ob, c, lam, qb * 256, SEQ, (char*)lds, wv);
    }
    {
        const int tid2 = otid(wv), lane2 = tid2 & 63, wid2 = __builtin_amdgcn_readfirstlane(tid2 >> 6);
        const int srow = lane2 >> 5, sc4 = (lane2 & 31) * 4;
        const float sc1 = 1.0f - (0.8f - 0.6f * expf(-0.3f * (float)layer));
        const float* gsub = kargs()->in[13] + (size_t)o * 256;
        const f32x4 g0 = *(const f32x4*)(gsub + sc4) * sc1, g1 = *(const f32x4*)(gsub + 128 + sc4) * sc1;
        const float* src = Ob + (size_t)(wid2 * 32 + srow) * DM + sc4;
        bf16_t* dst = OB + (row0 + wid2 * 32 + srow) * DM + h * 256 + sc4;
#pragma unroll 8
        for (int k = 0; k < 16; ++k) {
            const f32x4 a = *(const f32x4*)src, c = *(const f32x4*)(src + 128);
            float ss = ((a[0] * a[0] + a[1] * a[1]) + (a[2] * a[2] + a[3] * a[3])) + ((c[0] * c[0] + c[1] * c[1]) + (c[2] * c[2] + c[3] * c[3]));
            ss += DPP_F(ss, 0xB1); ss += DPP_F(ss, 0x4E); ss += DPP_F(ss, 0x141); ss += DPP_F(ss, 0x140); ss += SWZ_XOR(ss, 16);
            const float rr = 1.0f / sqrtf(ss * (1.0f / 256.0f) + EPS);
            const f32x4 y0 = a * rr * g0, y1 = c * rr * g1;
            u32x2 w0, w1; w0.x = cvt_pk_bf16(y0[0], y0[1]); w0.y = cvt_pk_bf16(y0[2], y0[3]); w1.x = cvt_pk_bf16(y1[0], y1[1]); w1.y = cvt_pk_bf16(y1[2], y1[3]);
            *(u32x2*)dst = w0; *(u32x2*)(dst + 128) = w1;
            src += 2 * DM; dst += 2 * DM;
        }
    }
}

constexpr int N_PHASES = 1 + 7 * DEPTH;
__global__ void __launch_bounds__(512, 2) mega(Args a_unused) {
    extern __shared__ __attribute__((aligned(16))) unsigned char lds[];
    const int wv = __builtin_amdgcn_readfirstlane(threadIdx.x >> 6);
    const int lo = kargs()->lo;
#pragma unroll 1
    for (int ph = lo; ph < kargs()->hi; ++ph) {
        KArgs ap = kargs();
        const int G = gridDim.x, bx = blockIdx.x;
        const int vcu = (G % 8 == 0) ? (bx % 8) * (G / 8) + bx / 8 : bx;
        unsigned char* ws = ap->ws;
        bf16_t* H = (bf16_t*)(ws + WS_H);
        unsigned char* BIG = ws + WS_BIG;
        float* MBUF = (float*)(ws + WS_MBUF);
        const int tid = otid(wv), wid = __builtin_amdgcn_readfirstlane(tid >> 6), lane = tid & 63;
        const int gw = vcu * 8 + wid, NGW = G * 8;
        if (ph == 0) {
#ifndef NO_PREP
            prep_phase(lds, vcu, G, wv);
#endif
        } else {
            const int l = (ph - 1) / 7, s = (ph - 1) % 7, e = l >> 1;
            const bool even = (l & 1) == 0;
            if (s == 0) {
                if (even) { pg8::Gemm g{H, (const bf16_t*)(ws + WS_WIN + e * SZ_WIN), M_TOK, IN_AB, DM}; pg8::StaticOrder S; S.init(M_TOK, IN_AB, G, bx);
                    pg8::EpiGemm1 E{(bf16_t*)(BIG + BIG_AG), (bf16_t*)(BIG + BIG_ZU), (bf16_t*)(BIG + BIG_GV)};
#ifndef NO_G1
                    pg8::gemm_phase<pg8::EpiGemm1, pg8::StaticOrder>((LAS unsigned char*)lds, g, S, E, wv);
#endif
                } else { pg8::Gemm g{H, (const bf16_t*)(ws + WS_WQKV + e * SZ_WQKV), M_TOK, QKV_N, DM}; pg8::StaticOrder S; S.init(M_TOK, QKV_N, G, bx);
                    pg8::EpiQKV E{(bf16_t*)(BIG + BIG_QKV), QKV_N, 8};
#ifndef NO_GQKV
                    pg8::gemm_phase<pg8::EpiQKV, pg8::StaticOrder>((LAS unsigned char*)lds, g, S, E, wv);
#endif
                }
            } else if (s == 1) {
                if (even) {
#ifndef NO_CONV
                    for (int it = vcu; it < 512; it += G)
                        conv_item(it, (const bf16_t*)(BIG + BIG_AG), ap->in[3] + (size_t)e * CONV_W * 1024, ap->in[4] + e * 1024, ap->in[5] + e * 1024, (bf16_t*)(BIG + BIG_CAT), lds, wv);
#endif
#ifndef NO_SGU
                    for (int it = vcu; it < 512; it += G)
                        sgu_item(it, (const bf16_t*)(BIG + BIG_GV), (const bf16_t*)(BIG + BIG_ZU), ap->in[6] + e * 1024, ap->in[7] + e * 1024, ap->in[8] + (size_t)e * 8 * 128 * 128, ap->in[9] + e * 8 * 128, (bf16_t*)(BIG + BIG_CAT), lds, wv);
#endif
                } else {
#ifndef NO_ATT
                    for (int it = vcu; it < 512; it += G)
                        attn_item(it, l, (const bf16_t*)(BIG + BIG_QKV), MBUF, (bf16_t*)(BIG + BIG_OB), lds, wv);
#endif
                }
            } else if (s == 2 || s == 5) {
                const bf16_t* A; const bf16_t* Bt; int K;
                if (s == 2) { K = DM; if (even) { A = (const bf16_t*)(BIG + BIG_CAT); Bt = (const bf16_t*)(ws + WS_WOAB + e * SZ_WOAB); } else { A = (const bf16_t*)(BIG + BIG_OB); Bt = (const bf16_t*)(ws + WS_WOC + e * SZ_WOC); } }
                else { K = DFF; A = (const bf16_t*)(BIG + BIG_ACT); Bt = (const bf16_t*)(ws + WS_WDN + l * SZ_WDN); }
                pg8::Gemm g{A, Bt, M_TOK, DM, K}; pg8::StaticOrder S; S.init(M_TOK, DM, G, bx);
                pg8::EpiQKV E{(bf16_t*)MBUF, DM, 0};
#ifndef NO_GF32
                pg8::gemm_phase<pg8::EpiQKV, pg8::StaticOrder>((LAS unsigned char*)lds, g, S, E, wv);
#endif
            } else if (s == 3) {
                const float* xin = (l == 0) ? ap->in[0] : ap->out;
                norm_phase((const bf16_t*)MBUF, ap->in[1] + (size_t)(l * 4 + 1) * DM, xin, ap->out, ap->in[1] + (size_t)(l * 4 + 2) * DM, H, gw, NGW, lane);
            } else if (s == 4) {
                pg8::Gemm g{H, (const bf16_t*)(ws + WS_WGU + l * SZ_WGU), M_TOK, 2 * DFF, DM}; pg8::StaticOrder S; S.init(M_TOK, 2 * DFF, G, bx);
                pg8::EpiSwiGLU E{(bf16_t*)(BIG + BIG_ACT), DFF};
#ifndef NO_GSW
                pg8::gemm_phase<pg8::EpiSwiGLU, pg8::StaticOrder>((LAS unsigned char*)lds, g, S, E, wv);
#endif
            } else {
                const bool lastl = (l == DEPTH - 1);
                norm_phase((const bf16_t*)MBUF, ap->in[1] + (size_t)(l * 4 + 3) * DM, ap->out, ap->out, lastl ? nullptr : ap->in[1] + (size_t)((l + 1) * 4 + 0) * DM, lastl ? nullptr : H, gw, NGW, lane);
            }
        }
        if (ph + 1 < kargs()->hi) { if (kargs()->coop) cg::this_grid().sync(); }
    }
}

extern "C" void kernel_launch(void* const* d_in, const int* in_sizes, int n_in, void* d_out, int out_size, void* d_ws, size_t ws_size, hipStream_t stream) {
    static int grid = 0;
    if (grid == 0) {
        if (n_in != 19 || in_sizes[0] != M_TOK * DM || out_size != M_TOK * DM || ws_size < WS_END) {
            fprintf(stderr, "kernel_launch: shape mismatch n_in %d in0 %d out %d ws %zu (need %zu)\n", n_in, n_in > 0 ? in_sizes[0] : -1, out_size, ws_size, (size_t)WS_END); grid = -1; return; }
        int dev = 0, cus = 0, per_cu = 0;
        if (hipGetDevice(&dev) != hipSuccess || hipDeviceGetAttribute(&cus, hipDeviceAttributeMultiprocessorCount, dev) != hipSuccess) { grid = -1; return; }
        if (hipFuncSetAttribute((const void*)mega, hipFuncAttributeMaxDynamicSharedMemorySize, LDS_BYTES) != hipSuccess) { fprintf(stderr, "kernel_launch: hipFuncSetAttribute failed\n"); grid = -1; return; }
        if (hipOccupancyMaxActiveBlocksPerMultiprocessor(&per_cu, (const void*)mega, 512, LDS_BYTES) != hipSuccess || per_cu < 1) { fprintf(stderr, "kernel_launch: occupancy query says %d\n", per_cu); per_cu = 1; }
        (void)hipGetLastError();
        grid = cus * 1;
        (void)per_cu;
    }
    if (grid < 0) return;
    Args a{};
    for (int i = 0; i < 19; ++i) a.in[i] = (const float*)d_in[i];
    a.out = (float*)d_out; a.ws = (unsigned char*)d_ws;
#if N_LAUNCH_MODE == 1
    for (int ph = 0; ph < N_PHASES; ++ph) { a.lo = ph; a.hi = ph + 1; a.coop = 0; a.pad = 0;
        int ptype = 0;
        if (ph > 0) { const int l_ = (ph - 1) / 7, s_ = (ph - 1) % 7; ptype = (s_ == 0) ? 1 : (s_ == 1) ? (((l_ & 1) == 0) ? 2 : 3) : (s_ == 2 || s_ == 5) ? 4 : (s_ == 4) ? 5 : 6; }
        const int nrep = ((DUP_MASK >> ptype) & 1) ? 2 : 1;
        for (int rep = 0; rep < nrep; ++rep) hipLaunchKernelGGL(mega, dim3(grid), dim3(512), LDS_BYTES, stream, a); }
#else
    a.lo = 0; a.hi = N_PHASES; a.coop = 1; a.pad = 0;
    void* args[] = {&a};
    hipError_t e = hipLaunchCooperativeKernel((const void*)mega, dim3(grid), dim3(512), args, LDS_BYTES, stream);
    if (e != hipSuccess) fprintf(stderr, "kernel_launch: cooperative launch failed: %s (grid %d)\n", hipGetErrorString(e), grid);
#endif
}
```
